# Optimizing an MI355X kernel written in HIP

```python
import jax, jax.numpy as jnp
from jax import lax
import numpy as np

D_MODEL = 1024
BATCH = 2
SEQ = 16384
DEPTH = 2

PLE_DIM = 256
N_MIXERS = 2
D_FF = 2816
FFN_HALF = 0.5
MLA_HEADS = 16
MLA_Q_RANK = 512
MLA_KV_RANK = 256
MLA_NOPE = 64
MLA_ROPE = 32
MLA_V = 64
ROPE_THETA = 10000.0
FOX_HEADS = 16
FOX_HEAD_DIM = 64
Q_BLOCK = 128
EPS = 1e-6
N_MLA_LAYERS = (DEPTH + N_MIXERS - 1) // N_MIXERS
N_FOX_LAYERS = DEPTH // N_MIXERS

kernel_name = "hybrid_mla_fox_macaron_ple"


def rms_norm(x, g):
    xf = x.astype(jnp.float32)
    y = xf * lax.rsqrt(jnp.mean(xf * xf, axis=-1, keepdims=True) + EPS)
    return (y * g.astype(jnp.float32)).astype(x.dtype)


def swiglu(x, w_in, w_out):
    gate, up = jnp.split(x @ w_in, 2, axis=-1)
    return (jax.nn.silu(gate) * up) @ w_out


def rope(x, pos):
    r = x.shape[-1]
    inv_freq = ROPE_THETA ** (-jnp.arange(0, r, 2, dtype=jnp.float32) / r)
    ang = pos.astype(jnp.float32)[:, :, None, None] * inv_freq
    cos = jnp.cos(ang).astype(x.dtype)
    sin = jnp.sin(ang).astype(x.dtype)
    x1, x2 = jnp.split(x, 2, axis=-1)
    return jnp.concatenate([x1 * cos - x2 * sin, x1 * sin + x2 * cos], axis=-1)


def block_causal_attention(q, k, v, decay=None):
    b, s, h, dk = q.shape
    dv = v.shape[-1]
    nb = s // Q_BLOCK
    scale = dk ** -0.5
    qb = q.reshape(b, nb, Q_BLOCK, h, dk).transpose(1, 0, 2, 3, 4)
    blk = jnp.arange(nb)
    k_pos = jnp.arange(s)
    c_k = None if decay is None else decay.transpose(0, 2, 1)

    def attend(qi, i, c_qi):
        logits = jnp.einsum('bqhd,bkhd->bhqk', qi, k).astype(jnp.float32) * scale
        if c_qi is not None:
            logits = logits + c_qi[:, :, :, None] - c_k[:, :, None, :]
        q_pos = i * Q_BLOCK + jnp.arange(Q_BLOCK)
        mask = k_pos[None, :] <= q_pos[:, None]
        logits = jnp.where(mask[None, None], logits, -jnp.inf)
        probs = jax.nn.softmax(logits, axis=-1)
        return jnp.einsum('bhqk,bkhd->bqhd', probs.astype(v.dtype), v)

    if decay is None:
        out = lax.map(lambda a: attend(a[0], a[1], None), (qb, blk))
    else:
        c_qb = decay.reshape(b, nb, Q_BLOCK, h).transpose(1, 0, 3, 2)
        out = lax.map(lambda a: attend(a[0], a[1], a[2]), (qb, blk, c_qb))
    return out.transpose(1, 0, 2, 3, 4).reshape(b, s, h, dv)


def mla_mixer(hn, pos, w_in, g_q_lat, w_uq, g_kv_lat, w_ukv, g_qn, g_kn, w_o):
    b, s, _ = hn.shape
    z = hn @ w_in
    c_q = z[..., :MLA_Q_RANK]
    c_kv = z[..., MLA_Q_RANK:MLA_Q_RANK + MLA_KV_RANK]
    k_pe = z[..., MLA_Q_RANK + MLA_KV_RANK:]
    q = (rms_norm(c_q, g_q_lat) @ w_uq).reshape(b, s, MLA_HEADS, MLA_NOPE + MLA_ROPE)
    kv = (rms_norm(c_kv, g_kv_lat) @ w_ukv).reshape(b, s, MLA_HEADS, MLA_NOPE + MLA_V)
    k_nope, v = kv[..., :MLA_NOPE], kv[..., MLA_NOPE:]
    k_pe_h = jnp.broadcast_to(k_pe[:, :, None, :], (b, s, MLA_HEADS, MLA_ROPE))
    k = jnp.concatenate([k_nope, k_pe_h], axis=-1)
    q = rms_norm(q, g_qn)
    k = rms_norm(k, g_kn)
    q = jnp.concatenate([q[..., :MLA_NOPE], rope(q[..., MLA_NOPE:], pos)], axis=-1)
    k = jnp.concatenate([k[..., :MLA_NOPE], rope(k[..., MLA_NOPE:], pos)], axis=-1)
    o = block_causal_attention(q, k, v)
    return o.reshape(b, s, MLA_HEADS * MLA_V) @ w_o


def fox_mixer(hn, w_in, b_f, g_qn, g_kn, w_o):
    b, s, _ = hn.shape
    hd = FOX_HEADS * FOX_HEAD_DIM
    z = hn @ w_in
    q = z[..., :hd].reshape(b, s, FOX_HEADS, FOX_HEAD_DIM)
    k = z[..., hd:2 * hd].reshape(b, s, FOX_HEADS, FOX_HEAD_DIM)
    v = z[..., 2 * hd:3 * hd].reshape(b, s, FOX_HEADS, FOX_HEAD_DIM)
    f_logit = z[..., 3 * hd:].astype(jnp.float32) + b_f.astype(jnp.float32)
    log_f = jax.nn.log_sigmoid(f_logit)
    decay = jnp.cumsum(log_f, axis=1)
    q = rms_norm(q, g_qn)
    k = rms_norm(k, g_kn)
    o = block_causal_attention(q, k, v, decay)
    return o.reshape(b, s, hd) @ w_o


def setup_inputs(seed: int = 0) -> dict:
    key = jax.random.key(seed)
    ks = iter(jax.random.split(key, 40))

    def dense(shape, fan_in):
        return jax.random.normal(next(ks), shape, jnp.float32) * (fan_in ** -0.5)

    def gain(shape):
        return 1.0 + 0.1 * jax.random.normal(next(ks), shape, jnp.float32)

    x = jax.random.normal(next(ks), (BATCH, SEQ, D_MODEL), jnp.float32)
    p = jax.random.normal(next(ks), (DEPTH, BATCH, SEQ, PLE_DIM), jnp.float32)
    positions = jnp.broadcast_to(jnp.arange(SEQ, dtype=jnp.int32), (BATCH, SEQ))
    na, nf = N_MLA_LAYERS, N_FOX_LAYERS
    fox_in = 3 * FOX_HEADS * FOX_HEAD_DIM + FOX_HEADS
    return {
        "x": x,
        "p": p,
        "positions": positions,
        "g_ffn1": gain((DEPTH, D_MODEL)),
        "g_mix": gain((DEPTH, D_MODEL)),
        "g_ffn2": gain((DEPTH, D_MODEL)),
        "g_ple": gain((DEPTH, D_MODEL)),
        "ffn1_w_in": dense((DEPTH, D_MODEL, 2 * D_FF), D_MODEL),
        "ffn1_w_out": dense((DEPTH, D_FF, D_MODEL), D_FF),
        "ffn2_w_in": dense((DEPTH, D_MODEL, 2 * D_FF), D_MODEL),
        "ffn2_w_out": dense((DEPTH, D_FF, D_MODEL), D_FF),
        "ple_w_proj": dense((DEPTH, PLE_DIM, D_MODEL), PLE_DIM),
        "ple_w_gate": dense((DEPTH, D_MODEL, D_MODEL), D_MODEL),
        "mla_w_in": dense((na, D_MODEL, MLA_Q_RANK + MLA_KV_RANK + MLA_ROPE), D_MODEL),
        "mla_g_q_lat": gain((na, MLA_Q_RANK)),
        "mla_w_uq": dense((na, MLA_Q_RANK, MLA_HEADS * (MLA_NOPE + MLA_ROPE)), MLA_Q_RANK),
        "mla_g_kv_lat": gain((na, MLA_KV_RANK)),
        "mla_w_ukv": dense((na, MLA_KV_RANK, MLA_HEADS * (MLA_NOPE + MLA_V)), MLA_KV_RANK),
        "mla_g_qn": gain((na, MLA_NOPE + MLA_ROPE)),
        "mla_g_kn": gain((na, MLA_NOPE + MLA_ROPE)),
        "mla_w_o": dense((na, MLA_HEADS * MLA_V, D_MODEL), MLA_HEADS * MLA_V),
        "fox_w_in": dense((nf, D_MODEL, fox_in), D_MODEL),
        "fox_b_f": jax.random.uniform(next(ks), (nf, FOX_HEADS), jnp.float32, 1.0, 4.0),
        "fox_g_qn": gain((nf, FOX_HEAD_DIM)),
        "fox_g_kn": gain((nf, FOX_HEAD_DIM)),
        "fox_w_o": dense((nf, FOX_HEADS * FOX_HEAD_DIM, D_MODEL), FOX_HEADS * FOX_HEAD_DIM),
    }


def reference(x, p, positions, g_ffn1, g_mix, g_ffn2, g_ple,
              ffn1_w_in, ffn1_w_out, ffn2_w_in, ffn2_w_out, ple_w_proj, ple_w_gate,
              mla_w_in, mla_g_q_lat, mla_w_uq, mla_g_kv_lat, mla_w_ukv,
              mla_g_qn, mla_g_kn, mla_w_o,
              fox_w_in, fox_b_f, fox_g_qn, fox_g_kn, fox_w_o):
    h = x
    for i in range(DEPTH):
        h = h + FFN_HALF * swiglu(rms_norm(h, g_ffn1[i]), ffn1_w_in[i], ffn1_w_out[i])
        hn = rms_norm(h, g_mix[i])
        j = i // N_MIXERS
        if i % N_MIXERS == 0:
            h = h + mla_mixer(hn, positions, mla_w_in[j], mla_g_q_lat[j], mla_w_uq[j],
                              mla_g_kv_lat[j], mla_w_ukv[j], mla_g_qn[j], mla_g_kn[j],
                              mla_w_o[j])
        else:
            h = h + fox_mixer(hn, fox_w_in[j], fox_b_f[j], fox_g_qn[j], fox_g_kn[j],
                              fox_w_o[j])
        h = h + FFN_HALF * swiglu(rms_norm(h, g_ffn2[i]), ffn2_w_in[i], ffn2_w_out[i])
        gate = jax.nn.sigmoid(rms_norm(h, g_ple[i]) @ ple_w_gate[i])
        h = h + gate * (p[i] @ ple_w_proj[i])
    return h
```

```cpp
#include <hip/hip_runtime.h>
#include <hip/hip_cooperative_groups.h>
#include <cstdio>
#include <cstdint>
namespace cg = cooperative_groups;

#define LAS __attribute__((address_space(3)))
typedef unsigned short bf16_t;
typedef short bf16x8 __attribute__((ext_vector_type(8)));
typedef short s16x4 __attribute__((ext_vector_type(4)));
typedef float f32x4 __attribute__((ext_vector_type(4)));
typedef float f32x16 __attribute__((ext_vector_type(16)));
typedef unsigned u32x4 __attribute__((ext_vector_type(4)));
typedef unsigned u32x2 __attribute__((ext_vector_type(2)));

constexpr int DM = 1024, SEQ = 16384, NB = 2, T = NB * SEQ, DFF = 2816, PLE = 256, NH = 16;
constexpr float EPS = 1e-6f;
constexpr float LOG2E = 1.4426950408889634f;

__device__ __forceinline__ unsigned f2bf(float f) { unsigned u = __builtin_bit_cast(unsigned, f); return (u + 0x7fffu + ((u >> 16) & 1u)) >> 16; }
typedef float f32x2v_t __attribute__((ext_vector_type(2))); typedef __bf16 bf16x2v_t __attribute__((ext_vector_type(2)));
__device__ __forceinline__ unsigned pk2(float lo, float hi) { f32x2v_t v = {lo, hi}; bf16x2v_t b = __builtin_convertvector(v, bf16x2v_t); return __builtin_bit_cast(unsigned, b); }
__device__ __forceinline__ float bf2f(unsigned short b) { return __builtin_bit_cast(float, (unsigned)b << 16); }
__device__ __forceinline__ float bflo(unsigned w) { return __builtin_bit_cast(float, w << 16); }
__device__ __forceinline__ float bfhi(unsigned w) { return __builtin_bit_cast(float, w & 0xffff0000u); }

namespace pg8 {
constexpr int BM = 256, BK = 64, HALF = 128, HTB = HALF * BK * 2, STAGE_BYTES = 8 * HTB, NXCD = 8, WGM = 8;
__host__ __device__ __forceinline__ int lds_byte(int r, int c) { const int st = (r >> 4) * 2 + (c >> 5), rr = r & 15, cc = c & 31, ob = rr * 64 + cc * 2; return st * 1024 + (ob ^ (((ob >> 9) & 1) << 5)); }
__host__ __device__ __forceinline__ void stage_rc(int b, int& R, int& C) { const int st = b / 1024, sb = b % 1024, swz = sb ^ (((sb >> 9) & 1) << 5); R = (st >> 1) * 16 + swz / 64; C = (st & 1) * 32 + (swz % 64) / 2; }
__host__ __device__ __forceinline__ int perm32(int rho) { const int n = rho >> 4, i = rho & 15; return 8 * (i >> 2) + 4 * n + (i & 3); }

struct Unit { int pm, pn; };
struct Gemm { const bf16_t* A; const bf16_t* Bt; int M, N, K, lda; };

struct StaticOrder {
    int nM, nN, nwg, G, c;
    __device__ void init(int M, int N, int G_, int c_) { nM = M / BM; nN = N / BM; nwg = nM * nN; G = G_; c = c_; }
    __device__ bool next(int i, Unit& u) const {
        const long L = (long)i * G + c; if (L >= nwg) return false;
        int wgid = (int)L; { const int q = nwg / NXCD, r = nwg % NXCD, xcd = wgid % NXCD, off = wgid / NXCD; wgid = (xcd < r ? xcd * (q + 1) : r * (q + 1) + (xcd - r) * q) + off; }
        const int nig = WGM * nN, gid = wgid / nig, fm = gid * WGM, gsz = (nM - fm) < WGM ? (nM - fm) : WGM;
        u.pm = fm + ((wgid % nig) % gsz); u.pn = (wgid % nig) / gsz; return true;
    }
};

__device__ __forceinline__ unsigned cvt_pk_bf16(float lo, float hi) { unsigned r; asm volatile("v_cvt_pk_bf16_f32 %0, %1, %2" : "=v"(r) : "v"(lo), "v"(hi)); return r; }

typedef f32x4 Acc[2][2][4][2];

struct RowStat { const float* st; unsigned mask; float invK; };
__device__ __forceinline__ void load_rstd(const RowStat& rs, int row0, int fq, float (&r)[2][4]) {
#pragma unroll
    for (int ai = 0; ai < 2; ++ai)
#pragma unroll
        for (int m = 0; m < 4; ++m) {
            const f32x4 v = *(const f32x4*)(rs.st + (size_t)(row0 + ai * HALF + m * 16) * 16 + 4 * fq);
            float s = ((rs.mask >> fq) & 1u) ? (v[0] + v[1]) + (v[2] + v[3]) : 0.f;
            s += __shfl_xor(s, 16); s += __shfl_xor(s, 32);
            r[ai][m] = __builtin_amdgcn_rsqf(s * rs.invK + EPS);
        }
}

template <bool HAS_RS, bool HAS_ST, bool HAS_FLOG> struct EpiBf16 {
    static constexpr bool PERM = true;
    bf16_t* b0; bf16_t* b1; bf16_t* bv; int ld0, ld1, vt;
    RowStat rs; float* st_out; float* flg; const float* bfv; int flog_pn;
    const float* gqp; const float* gkp; bf16_t* kimg;
    __device__ __forceinline__ void operator()(const Acc& acc, const Unit& u, int wr, int wc, int fr, int fq) const {
        const int row0 = u.pm * BM + wr * 64 + fr;
        float rstd[2][4];
        if constexpr (HAS_RS) load_rstd(rs, row0, fq, rstd);
        else {
#pragma unroll
            for (int ai = 0; ai < 2; ++ai)
#pragma unroll
                for (int m = 0; m < 4; ++m) rstd[ai][m] = 1.f; }
        if (HAS_FLOG && u.pn == flog_pn) {
            if (wc == 0 && fq < 2) {
#pragma unroll
                for (int ai = 0; ai < 2; ++ai)
#pragma unroll
                    for (int m = 0; m < 4; ++m)
#pragma unroll
                        for (int n = 0; n < 2; ++n) { const f32x4 a = acc[ai][0][m][n]; f32x4 o;
#pragma unroll
                            for (int j = 0; j < 4; ++j) { const float x = a[j] * rstd[ai][m] + bfv[8 * fq + 4 * n + j]; o[j] = fminf(x, 0.f) - log1pf(__expf(-fabsf(x))); }
                            *(f32x4*)(flg + (size_t)(row0 + ai * HALF + m * 16) * 16 + 8 * fq + 4 * n) = o; }
            }
            return;
        }
        if constexpr (HAS_FLOG) {
            if (u.pn < 8) {
                const bool isq = u.pn < 4; const int head = 4 * (u.pn & 3) + wc; const float* gp = isq ? gqp : gkp;
                f32x4 gl[2][2];
#pragma unroll
                for (int bj = 0; bj < 2; ++bj)
#pragma unroll
                    for (int n = 0; n < 2; ++n) gl[bj][n] = *(const f32x4*)(gp + 32 * bj + 8 * fq + 4 * n);
                const float qsc = isq ? 0.125f * LOG2E : 1.f;
#pragma unroll
                for (int ai = 0; ai < 2; ++ai)
#pragma unroll
                    for (int m = 0; m < 4; ++m) { const int row = row0 + ai * HALF + m * 16; const float rr = rstd[ai][m]; float ss = 0.f; f32x4 z[2][2];
#pragma unroll
                        for (int bj = 0; bj < 2; ++bj)
#pragma unroll
                            for (int n = 0; n < 2; ++n) { z[bj][n] = acc[ai][bj][m][n] * rr; ss += (z[bj][n][0] * z[bj][n][0] + z[bj][n][1] * z[bj][n][1]) + (z[bj][n][2] * z[bj][n][2] + z[bj][n][3] * z[bj][n][3]); }
                        ss += __shfl_xor(ss, 16); ss += __shfl_xor(ss, 32);
                        const float rh = __builtin_amdgcn_rsqf(ss * (1.f / 64.f) + EPS) * qsc;
                        const int bb = row >> 14, sq = row & (SEQ - 1);
#pragma unroll
                        for (int bj = 0; bj < 2; ++bj) { const f32x4 v0 = z[bj][0] * rh * gl[bj][0], v1 = z[bj][1] * rh * gl[bj][1];
                            u32x4 w; w.x = cvt_pk_bf16(v0[0], v0[1]); w.y = cvt_pk_bf16(v0[2], v0[3]); w.z = cvt_pk_bf16(v1[0], v1[1]); w.w = cvt_pk_bf16(v1[2], v1[3]);
                            bf16_t* dst = isq ? b0 + (size_t)row * 1024 + head * 64 + 32 * bj + 8 * fq
                                              : kimg + ((size_t)((bb * NH + head) * (SEQ / 64) + (sq >> 6))) * (10 * 512) + (4 * bj + fq) * 512 + (sq & 63) * 8;
                            *(u32x4*)dst = w; } }
                return;
            }
        }
        const int t = u.pn >> 2; const bool isv = (t == vt); bf16_t* base = t == 0 ? b0 : b1; const int ldc = t == 0 ? ld0 : ld1;
        const int col0 = (u.pn & 3) * BM + wc * 32 + 8 * fq;
#pragma unroll
        for (int ai = 0; ai < 2; ++ai)
#pragma unroll
            for (int m = 0; m < 4; ++m) { const int row = row0 + ai * HALF + m * 16; const float rr = rstd[ai][m]; float ss = 0.f;
                bf16_t* rowp;
                if (isv) {
                    const int bb = row >> 14, sq = row & (SEQ - 1);
                    rowp = bv + ((size_t)((bb * NH + (col0 >> 6)) * (SEQ / 64) + (sq >> 6))) * 4096 + ((col0 >> 5) & 1) * 2048 + (sq & 63) * 32 + (col0 & 31);
                } else rowp = base + (size_t)row * ldc + col0;
                const size_t bjstep = isv ? (size_t)2 * (SEQ / 64) * 4096 : (size_t)HALF;
#pragma unroll
                for (int bj = 0; bj < 2; ++bj) { const f32x4 v0 = acc[ai][bj][m][0] * rr, v1 = acc[ai][bj][m][1] * rr;
                    ss += (v0[0] * v0[0] + v0[1] * v0[1]) + (v0[2] * v0[2] + v0[3] * v0[3]) + (v1[0] * v1[0] + v1[1] * v1[1]) + (v1[2] * v1[2] + v1[3] * v1[3]);
                    u32x4 w; w.x = cvt_pk_bf16(v0[0], v0[1]); w.y = cvt_pk_bf16(v0[2], v0[3]); w.z = cvt_pk_bf16(v1[0], v1[1]); w.w = cvt_pk_bf16(v1[2], v1[3]);
                    *(u32x4*)(rowp + bj * bjstep) = w; }
                if constexpr (HAS_ST) { ss += __shfl_xor(ss, 16); ss += __shfl_xor(ss, 32); if (fq == 0) st_out[(size_t)row * 16 + ((u.pn * 4 + wc) & 15)] = ss; } }
    }
};

struct EpiSwiGLU {
    static constexpr bool PERM = true;
    bf16_t* O; int ldc; RowStat rs;
    __device__ __forceinline__ void operator()(const Acc& acc, const Unit& u, int wr, int wc, int fr, int fq) const {
        const int row0 = u.pm * BM + wr * 64 + fr;
        float rstd[2][4]; load_rstd(rs, row0, fq, rstd);
        const int col0 = u.pn * HALF + wc * 32 + 8 * fq;
#pragma unroll
        for (int ai = 0; ai < 2; ++ai)
#pragma unroll
            for (int m = 0; m < 4; ++m) { const float rr = rstd[ai][m]; float o[8];
#pragma unroll
                for (int n = 0; n < 2; ++n)
#pragma unroll
                    for (int j = 0; j < 4; ++j) { const float g = acc[ai][0][m][n][j] * rr, up = acc[ai][1][m][n][j] * rr;
                        o[4 * n + j] = g * __builtin_amdgcn_rcpf(1.f + __builtin_amdgcn_exp2f(-g * LOG2E)) * up; }
                u32x4 w; w.x = cvt_pk_bf16(o[0], o[1]); w.y = cvt_pk_bf16(o[2], o[3]); w.z = cvt_pk_bf16(o[4], o[5]); w.w = cvt_pk_bf16(o[6], o[7]);
                *(u32x4*)(O + (size_t)(row0 + ai * HALF + m * 16) * ldc + col0) = w; }
    }
};

template <bool IS_PLE> struct EpiRes {
    static constexpr bool PERM = true;
    const float* base; float* out; bf16_t* hb; float* st_out; float alpha; const bf16_t* pp; RowStat rs;
    __device__ __forceinline__ void operator()(const Acc& acc, const Unit& u, int wr, int wc, int fr, int fq) const {
        const int row0 = u.pm * BM + wr * 64 + fr;
        float rstd[2][4];
        if constexpr (IS_PLE) load_rstd(rs, row0, fq, rstd);
        const int col0 = u.pn * BM + wc * 32 + 8 * fq;
#pragma unroll
        for (int ai = 0; ai < 2; ++ai)
#pragma unroll
            for (int m = 0; m < 4; ++m) { const int row = row0 + ai * HALF + m * 16; const size_t off = (size_t)row * DM + col0; float ss = 0.f;
#pragma unroll
                for (int bj = 0; bj < 2; ++bj) {
                    const f32x4 h0 = *(const f32x4*)(base + off + bj * HALF), h1 = *(const f32x4*)(base + off + bj * HALF + 4);
                    f32x4 v0, v1;
                    if constexpr (IS_PLE) { const u32x4 pw = *(const u32x4*)(pp + off + bj * HALF); const float rr = rstd[ai][m] * LOG2E;
                        const f32x4 a0 = acc[ai][bj][m][0] * rr, a1 = acc[ai][bj][m][1] * rr;
                        f32x4 s0, s1;
#pragma unroll
                        for (int j = 0; j < 4; ++j) { s0[j] = __builtin_amdgcn_rcpf(1.f + __builtin_amdgcn_exp2f(-a0[j])); s1[j] = __builtin_amdgcn_rcpf(1.f + __builtin_amdgcn_exp2f(-a1[j])); }
                        v0 = h0 + s0 * (f32x4){bflo(pw.x), bfhi(pw.x), bflo(pw.y), bfhi(pw.y)};
                        v1 = h1 + s1 * (f32x4){bflo(pw.z), bfhi(pw.z), bflo(pw.w), bfhi(pw.w)};
                    } else { v0 = h0 + acc[ai][bj][m][0] * alpha; v1 = h1 + acc[ai][bj][m][1] * alpha; }
                    *(f32x4*)(out + off + bj * HALF) = v0; *(f32x4*)(out + off + bj * HALF + 4) = v1;
                    ss += (v0[0] * v0[0] + v0[1] * v0[1]) + (v0[2] * v0[2] + v0[3] * v0[3]) + (v1[0] * v1[0] + v1[1] * v1[1]) + (v1[2] * v1[2] + v1[3] * v1[3]);
                    u32x4 w; w.x = cvt_pk_bf16(v0[0], v0[1]); w.y = cvt_pk_bf16(v0[2], v0[3]); w.z = cvt_pk_bf16(v1[0], v1[1]); w.w = cvt_pk_bf16(v1[2], v1[3]);
                    *(u32x4*)(hb + off + bj * HALF) = w; }
                ss += __shfl_xor(ss, 16); ss += __shfl_xor(ss, 32); if (fq == 0) st_out[(size_t)row * 16 + u.pn * 4 + wc] = ss;
                if (m & 1) asm volatile("" ::: "memory"); }
    }
};

template <class Epi, bool ALIGN_EPI, bool SP2>
__device__ __forceinline__ void gemm_phase(LAS unsigned char* lds, const Gemm g, const StaticOrder& S, const Epi& E) {
    int tid_ = threadIdx.x; asm volatile("" : "+v"(tid_));
    const int tid = tid_, wid = __builtin_amdgcn_readfirstlane(tid >> 6), lane = tid & 63, wr = wid >> 2, wc = wid & 3, fr = lane & 15, fq = lane >> 4;
    const int K = g.K, nt = K / BK, lda = g.lda;
    unsigned voffA[2], voffB[2];
#pragma unroll
    for (int i = 0; i < 2; ++i) { int R, C; stage_rc(tid * 16 + i * 8192, R, C); const int Rb = Epi::PERM ? ((R & ~31) + perm32(R & 31)) : R;
        voffA[i] = (unsigned)(R * lda + C) * 2u; voffB[i] = (unsigned)(Rb * K + C) * 2u; }
    const size_t kstep = (size_t)(BK * 2);
    const size_t hstepA = (size_t)HALF * lda * 2, hstepB = (size_t)HALF * K * 2;
    const size_t tstepA = 2 * hstepA, tstepB = 2 * hstepB;
    const unsigned ldsw = (unsigned)wid * 1024u;
    const int aoff = lds_byte(wr * 64 + fr, fq * 8), boff = lds_byte(wc * 32 + fr, fq * 8);
#define PG8_SA(b, h) (((b) * 2 + (h)) * HTB)
#define PG8_SB(b, h) ((4 + (b) * 2 + (h)) * HTB)
#define PG8_STAGE(bufoff, gbase, voff) do { _Pragma("unroll") for (int _i = 0; _i < 2; ++_i) \
        __builtin_amdgcn_global_load_lds((const unsigned*)((const char*)(gbase) + (voff)[_i]), (LAS unsigned*)(lds + (bufoff) + ldsw + _i * 8192), 16, 0, 0); } while (0)
#define PG8_LDA(dst, b, h) do { _Pragma("unroll") for (int m = 0; m < 4; ++m) _Pragma("unroll") for (int k = 0; k < 2; ++k) dst[m][k] = *(const LAS bf16x8*)(lds + PG8_SA(b, h) + aoff + m * 2048 + k * 1024); } while (0)
#define PG8_LDB(dst, b, h) do { _Pragma("unroll") for (int n = 0; n < 2; ++n) _Pragma("unroll") for (int k = 0; k < 2; ++k) dst[n][k] = *(const LAS bf16x8*)(lds + PG8_SB(b, h) + boff + n * 2048 + k * 1024); } while (0)
#define PG8_MMA(ai, bj, At, Bt) do { __builtin_amdgcn_s_setprio(1); _Pragma("unroll") for (int m = 0; m < 4; ++m) _Pragma("unroll") for (int n = 0; n < 2; ++n) _Pragma("unroll") for (int k = 0; k < 2; ++k) \
        acc[ai][bj][m][n] = __builtin_amdgcn_mfma_f32_16x16x32_bf16(Bt[n][k], At[m][k], acc[ai][bj][m][n], 0, 0, 0); __builtin_amdgcn_s_setprio(0); } while (0)
#define PG8_WAIT_V(n) asm volatile("s_waitcnt vmcnt(" #n ")" ::: "memory")
#define PG8_WAIT_L(n) asm volatile("s_waitcnt lgkmcnt(" #n ")" ::: "memory")
#define PG8_BAR __builtin_amdgcn_s_barrier()
#define PG8_SCHED __builtin_amdgcn_sched_barrier(0)
    Unit cur, nxt; int ui = 0;
    if (!S.next(0, cur)) return;
    Acc acc;
#pragma unroll
    for (int a = 0; a < 2; ++a)
#pragma unroll
        for (int b = 0; b < 2; ++b)
#pragma unroll
            for (int m = 0; m < 4; ++m)
#pragma unroll
                for (int n = 0; n < 2; ++n) acc[a][b][m][n] = (f32x4){0.f, 0.f, 0.f, 0.f};
    bf16x8 At[4][2], B0[2][2], B1[2][2];
    const char* cA = (const char*)g.A + (size_t)cur.pm * tstepA; const char* cB = (const char*)g.Bt + (size_t)cur.pn * tstepB;
    if constexpr (SP2) {
        PG8_STAGE(PG8_SB(0, 0), cB, voffB); PG8_STAGE(PG8_SB(0, 1), cB + hstepB, voffB); PG8_STAGE(PG8_SA(0, 0), cA, voffA); PG8_STAGE(PG8_SA(0, 1), cA + hstepA, voffA);
        if (wr == 1) PG8_BAR;
        PG8_WAIT_V(2); PG8_BAR;
        PG8_STAGE(PG8_SB(1, 0), cB + kstep, voffB); PG8_STAGE(PG8_SA(1, 0), cA + kstep, voffA); PG8_STAGE(PG8_SB(1, 1), cB + hstepB + kstep, voffB);
        PG8_WAIT_V(6); PG8_BAR;
    } else {
        PG8_STAGE(PG8_SB(0, 0), cB, voffB); PG8_STAGE(PG8_SA(0, 0), cA, voffA); PG8_STAGE(PG8_SB(0, 1), cB + hstepB, voffB); PG8_STAGE(PG8_SA(0, 1), cA + hstepA, voffA);
        if (wr == 1) PG8_BAR;
        PG8_WAIT_V(4); PG8_BAR;
        PG8_STAGE(PG8_SB(1, 0), cB + kstep, voffB); PG8_STAGE(PG8_SA(1, 0), cA + kstep, voffA); PG8_STAGE(PG8_SB(1, 1), cB + hstepB + kstep, voffB);
        PG8_WAIT_V(6); PG8_BAR;
    }
    for (;;) {
        const bool has_next = S.next(ui + 1, nxt);
        const char* nA = has_next ? (const char*)g.A + (size_t)nxt.pm * tstepA : cA; const char* nB = has_next ? (const char*)g.Bt + (size_t)nxt.pn * tstepB : cB;
        for (int t = 0; t < nt; t += 2) {
            const bool last = (t == nt - 2);
            const char* a1 = cA + (size_t)(t + 1) * kstep;
            const char* a2 = last ? nA : cA + (size_t)(t + 2) * kstep; const char* b2 = last ? nB : cB + (size_t)(t + 2) * kstep;
            const char* a3 = a2 + kstep; const char* b3 = b2 + kstep;
            if constexpr (SP2) {
            PG8_LDB(B0, 0, 0); PG8_LDB(B1, 0, 1); PG8_SCHED; PG8_LDA(At, 0, 0); PG8_STAGE(PG8_SA(1, 1), a1 + hstepA, voffA);
            PG8_WAIT_V(8); PG8_WAIT_L(0); PG8_BAR; PG8_MMA(0, 0, At, B0); PG8_MMA(0, 1, At, B1); PG8_BAR; PG8_SCHED;
            PG8_LDA(At, 0, 1); PG8_STAGE(PG8_SB(0, 0), b2, voffB); PG8_STAGE(PG8_SB(0, 1), b2 + hstepB, voffB); PG8_STAGE(PG8_SA(0, 0), a2, voffA);
            PG8_WAIT_V(8); PG8_WAIT_L(0); PG8_BAR; PG8_MMA(1, 0, At, B0); PG8_MMA(1, 1, At, B1); PG8_BAR; PG8_SCHED;
            PG8_LDB(B0, 1, 0); PG8_LDB(B1, 1, 1); PG8_SCHED; PG8_LDA(At, 1, 0); PG8_STAGE(PG8_SA(0, 1), a2 + hstepA, voffA);
            PG8_WAIT_V(8); PG8_WAIT_L(0); PG8_BAR; PG8_MMA(0, 0, At, B0); PG8_MMA(0, 1, At, B1); PG8_BAR; PG8_SCHED;
            PG8_LDA(At, 1, 1); PG8_STAGE(PG8_SB(1, 0), b3, voffB); PG8_STAGE(PG8_SB(1, 1), b3 + hstepB, voffB); PG8_STAGE(PG8_SA(1, 0), a3, voffA);
            PG8_WAIT_V(8); PG8_WAIT_L(0); PG8_BAR; PG8_MMA(1, 0, At, B0); PG8_MMA(1, 1, At, B1); PG8_BAR; PG8_SCHED;
            } else {
            PG8_LDB(B0, 0, 0); PG8_SCHED; PG8_LDA(At, 0, 0); PG8_STAGE(PG8_SA(1, 1), a1 + hstepA, voffA);
            PG8_WAIT_L(8); PG8_BAR; PG8_WAIT_L(0); PG8_MMA(0, 0, At, B0); PG8_BAR; PG8_SCHED;
            PG8_LDB(B1, 0, 1); PG8_STAGE(PG8_SB(0, 0), b2, voffB);
            PG8_BAR; PG8_WAIT_L(0); PG8_MMA(0, 1, At, B1); PG8_BAR;
            PG8_LDA(At, 0, 1); PG8_STAGE(PG8_SA(0, 0), a2, voffA);
            PG8_BAR; PG8_WAIT_L(0); PG8_MMA(1, 0, At, B0); PG8_BAR; PG8_SCHED;
            PG8_STAGE(PG8_SB(0, 1), b2 + hstepB, voffB);
            PG8_WAIT_V(6); PG8_BAR; PG8_MMA(1, 1, At, B1); PG8_BAR;
            PG8_LDB(B0, 1, 0); PG8_SCHED; PG8_LDA(At, 1, 0); PG8_STAGE(PG8_SA(0, 1), a2 + hstepA, voffA);
            PG8_WAIT_L(8); PG8_BAR; PG8_WAIT_L(0); PG8_MMA(0, 0, At, B0); PG8_BAR; PG8_SCHED;
            PG8_LDB(B1, 1, 1); PG8_STAGE(PG8_SB(1, 0), b3, voffB);
            PG8_BAR; PG8_WAIT_L(0); PG8_MMA(0, 1, At, B1); PG8_BAR;
            PG8_LDA(At, 1, 1); PG8_STAGE(PG8_SA(1, 0), a3, voffA);
            PG8_BAR; PG8_WAIT_L(0); PG8_MMA(1, 0, At, B0); PG8_BAR; PG8_SCHED;
            PG8_STAGE(PG8_SB(1, 1), b3 + hstepB, voffB);
            PG8_WAIT_V(6); PG8_BAR; PG8_MMA(1, 1, At, B1); PG8_BAR;
            }
        }
        if constexpr (ALIGN_EPI) { if (wr == 0) PG8_BAR; }
        E(acc, cur, wr, wc, fr, fq);
        if (!has_next) break;
#pragma unroll
        for (int a = 0; a < 2; ++a)
#pragma unroll
            for (int b = 0; b < 2; ++b)
#pragma unroll
                for (int m = 0; m < 4; ++m)
#pragma unroll
                    for (int n = 0; n < 2; ++n) acc[a][b][m][n] = (f32x4){0.f, 0.f, 0.f, 0.f};
        cur = nxt; cA = nA; cB = nB; ++ui;
        if constexpr (ALIGN_EPI) { if (wr == 1) PG8_BAR; }
    }
    PG8_WAIT_V(0);
    if constexpr (!ALIGN_EPI) { if (wr == 0) PG8_BAR; }
    PG8_BAR;
#undef PG8_SA
#undef PG8_SB
#undef PG8_STAGE
#undef PG8_LDA
#undef PG8_LDB
#undef PG8_MMA
#undef PG8_WAIT_V
#undef PG8_WAIT_L
#undef PG8_BAR
#undef PG8_SCHED
}
}

namespace att {
constexpr int NQB = SEQ / 256, VSLOT = 8192;
constexpr int L_K = 0, L_V = 4 * 12288  , L_WS = L_V + 3 * VSLOT, L_OST = L_WS + 2048, L_BYTES = L_OST + 8 * 4096;
constexpr float THR = 8.f;
__device__ __forceinline__ int crow(int r, int hi) { return (r & 3) + 8 * (r >> 2) + 4 * hi; }
__device__ __forceinline__ void glds16(const void* gsrc, unsigned lds_dst) { unsigned keep;
    asm volatile("s_mov_b32 %0, m0\n\ts_mov_b32 m0, %2\n\ts_nop 0\n\tglobal_load_lds_dwordx4 %1, off\n\ts_mov_b32 m0, %0" : "=&s"(keep) : "v"(gsrc), "s"(lds_dst) : "memory"); }
__device__ __forceinline__ void glds16s(const void* sbase, unsigned voff, unsigned lds_dst) { unsigned keep;
    asm volatile("s_mov_b32 %0, m0\n\ts_mov_b32 m0, %3\n\ts_nop 0\n\tglobal_load_lds_dwordx4 %1, %2\n\ts_mov_b32 m0, %0" : "=&s"(keep) : "v"(voff), "s"(sbase), "s"(lds_dst) : "memory"); }
typedef short v4i16_t __attribute__((ext_vector_type(4)));
typedef LAS const char* lds_cptr;
__device__ __forceinline__ s16x4 vtr(lds_cptr p) { return __builtin_bit_cast(s16x4, __builtin_amdgcn_ds_read_tr16_b64_v4i16((LAS v4i16_t*)p)); }
typedef float f32x2_t __attribute__((ext_vector_type(2))); typedef __bf16 bf16x2_t __attribute__((ext_vector_type(2)));
__device__ __forceinline__ unsigned cvtpk(float lo, float hi) { f32x2_t v = {lo, hi}; bf16x2_t b = __builtin_convertvector(v, bf16x2_t); return __builtin_bit_cast(unsigned, b); }
#ifndef ATT_EXP_H1
#define ATT_EXP_H1 0
#endif
#define ATT_WAIT_BAR(N) asm volatile("s_waitcnt vmcnt(" #N ") lgkmcnt(0)\n\ts_barrier" ::: "memory")

template <int NKC, bool FIXREF, bool QNORM>
__device__ __forceinline__ void attn_unit(int b, int h, int qb, const bf16_t* Qm, const bf16_t* Qa, const bf16_t* Km, const bf16_t* Ka, const bf16_t* V, bf16_t* O, unsigned char* shm, const float* cg, float sbound, const float* gqn, const int* posp) {
    constexpr int AUGW = 16 * NKC - 64, NCH = 2 * NKC, KSLOT = NCH * 1024, NX = NCH - 8, APITCH = 16 * AUGW;
    int tid_ = threadIdx.x; asm volatile("" : "+v"(tid_));
    const int tid = tid_, lane = tid & 63, r32 = lane & 31, hi = lane >> 5; const int wid = __builtin_amdgcn_readfirstlane(tid >> 6);
    const long rowbase = (long)b * SEQ; const int q0 = qb * 256;
    int T0 = 0;
    if (cg) { const float cq0 = cg[((size_t)rowbase + q0) * 16 + h]; bool skp = false;
        if (lane < qb) { const float ck = cg[((size_t)rowbase + 256 * lane + 255) * 16 + h]; skp = (cq0 - ck) < -(2.f * sbound + 75.f); }
        T0 = 4 * (int)__popcll(__ballot(skp)); }
    const int NT = (q0 + 256) / 64 - T0;
    const unsigned lds0 = (unsigned)(uintptr_t)shm;
    LAS unsigned char* shm3 = (LAS unsigned char*)shm;
    LAS float* wsf = (LAS float*)(shm3 + L_WS) + wid * 64;
    const bf16_t* ksrc0 = Km + (size_t)(b * NH + h) * (SEQ / 64) * (KSLOT / 2) + wid * 512;
    const bf16_t* ksrc1 = ksrc0 + 8 * 512;
    const bf16_t* vsrc = V + (size_t)(b * NH + h) * (SEQ / 64) * 4096 + wid * 512;
    const unsigned dvoff = (unsigned)lane * 16u;
    const unsigned kdst0 = lds0 + L_K + wid * 1024, kdst1 = lds0 + L_K + (8 + wid) * 1024, vdst = lds0 + L_V + wid * 1024;
#define ATT_DMA_K(t, s) do { glds16s(ksrc0 + (long)(T0 + (t)) * (KSLOT / 2), dvoff, (unsigned)__builtin_amdgcn_readfirstlane(kdst0 + (s) * KSLOT)); \
        if (wid < NX) glds16s(ksrc1 + (long)(T0 + (t)) * (KSLOT / 2), dvoff, (unsigned)__builtin_amdgcn_readfirstlane(kdst1 + (s) * KSLOT)); } while (0)
#define ATT_DMA_V(t, s) glds16s(vsrc + (long)(T0 + (t)) * 4096, dvoff, (unsigned)__builtin_amdgcn_readfirstlane(vdst + (s) * VSLOT))
#define ATT_DMA(t, s) do { ATT_DMA_K(t, s); ATT_DMA_V(t, s); } while (0)
    ATT_DMA_K(0, 0);
    bf16x8 qr[NKC];
    { const bf16_t* Qrow = Qm + (rowbase + q0 + wid * 32 + r32) * 1024 + h * 64 + hi * 8;
      const bf16_t* Qarow = Qa + (rowbase + q0 + wid * 32 + r32) * APITCH + h * AUGW + hi * 8;
#pragma unroll
      for (int d0 = 0; d0 < 4; ++d0) qr[d0] = *(const bf16x8*)(Qrow + d0 * 16);
#pragma unroll
      for (int d0 = 4; d0 < NKC; ++d0) qr[d0] = *(const bf16x8*)(Qarow + (d0 - 4) * 16); }
    ATT_DMA_K(1, 1); ATT_DMA_K(2, 2); ATT_DMA_V(0, 0);
    if constexpr (QNORM) {
        static_assert(!QNORM || NKC == 6, "QNORM is the MLA (96-dim) form");
        float v[NKC][8]; float ss = 0.f;
#pragma unroll
        for (int d0 = 0; d0 < NKC; ++d0)
#pragma unroll
            for (int j = 0; j < 4; ++j) { const unsigned w = (unsigned)(unsigned short)qr[d0][2 * j] | ((unsigned)(unsigned short)qr[d0][2 * j + 1] << 16); v[d0][2 * j] = bflo(w); v[d0][2 * j + 1] = bfhi(w); }
#pragma unroll
        for (int d0 = 0; d0 < NKC; ++d0)
#pragma unroll
            for (int j = 0; j < 8; ++j) ss += v[d0][j] * v[d0][j];
        { auto rr = __builtin_amdgcn_permlane32_swap(__float_as_uint(ss), __float_as_uint(ss), false, false); ss = __uint_as_float(rr[0]) + __uint_as_float(rr[1]); }
        const float rq = __builtin_amdgcn_rsqf(ss * (1.f / 96.f) + EPS) * (0.10206207261596577f * LOG2E);
#pragma unroll
        for (int d0 = 0; d0 < NKC; ++d0) { const f32x4 g0 = *(const f32x4*)(gqn + 16 * d0 + 8 * hi), g1 = *(const f32x4*)(gqn + 16 * d0 + 8 * hi + 4);
#pragma unroll
            for (int j = 0; j < 4; ++j) { v[d0][j] *= rq * g0[j]; v[d0][4 + j] *= rq * g1[j]; } }
        const float pf = (float)posp[rowbase + q0 + wid * 32 + r32];
#pragma unroll
        for (int j = 0; j < 8; ++j) { const float invf = exp2f(-(float)(8 * hi + j) * 0.8304820237218406f);
            const float ang = pf * invf; const double rev = (double)ang * 0.15915494309189535; const float fr = (float)(rev - __builtin_rint(rev));
            const float cs = __builtin_amdgcn_cosf(fr), sn = __builtin_amdgcn_sinf(fr);
            const float x1 = v[4][j], x2 = v[5][j]; v[4][j] = x1 * cs - x2 * sn; v[5][j] = x1 * sn + x2 * cs; }
#pragma unroll
        for (int d0 = 0; d0 < NKC; ++d0) { u32x4 w; w.x = cvtpk(v[d0][0], v[d0][1]); w.y = cvtpk(v[d0][2], v[d0][3]); w.z = cvtpk(v[d0][4], v[d0][5]); w.w = cvtpk(v[d0][6], v[d0][7]); qr[d0] = __builtin_bit_cast(bf16x8, w); }
    }
    const lds_cptr kp0 = (lds_cptr)shm3 + L_K + hi * 1024 + r32 * 16;
    const lds_cptr vp0 = (lds_cptr)shm3 + L_V + ((lane >> 4) & 1) * 32 + (lane & 3) * 8 + (4 * hi + ((lane & 15) >> 2)) * 64;
    float mhat = 0.f, l_reg = 0.f; f32x16 o0 = {}, o1 = {}; f32x16 negm = {};
    f32x16 pA0, pA1, pB0, pB1;
    const int qrel = wid * 32 + r32;
#define ATT_SB() __builtin_amdgcn_sched_barrier(0)
#define ATT_PIN(x) asm volatile("" : "+v"(x))
#define ATT_MFMA(a, b, c) __builtin_amdgcn_mfma_f32_32x32x16_bf16(a, b, c, 0, 0, 0)
#define ATT_NWAIT() do { if (wid < NX) ATT_WAIT_BAR(3); else ATT_WAIT_BAR(2); } while (0)
#define ATT_TOPW(t) do { if ((t) + 3 < NT) ATT_NWAIT(); else ATT_WAIT_BAR(0); } while (0)
#define ATT_TOPD(t) do { if ((t) + 4 < NT) ATT_DMA_K((t) + 4, (t) & 3); if ((t) + 2 < NT) ATT_DMA_V((t) + 2, ((t) + 2) % 3); } while (0)
#define ATT_MASK(C0, C1, tt) do { const int jb_ = (tt) - (NT - 4); if (jb_ >= 0) { const int kb_ = 64 * jb_ + 4 * hi; \
        _Pragma("unroll") for (int r = 0; r < 16; ++r) { const int kv = kb_ + (r & 3) + 8 * (r >> 2); if (kv > qrel) C0[r] = -INFINITY; if (kv + 32 > qrel) C1[r] = -INFINITY; } } } while (0)
#define ATT_MX3(a, b, c) __builtin_fmaxf(__builtin_fmaxf((a), (b)), (c))
#define ATT_ROWMAX(C0, C1, rm) do { float a_ = ATT_MX3(C0[0], C0[1], C1[0]), b_ = ATT_MX3(C0[2], C0[3], C1[1]); a_ = ATT_MX3(a_, C1[2], C1[3]); \
        _Pragma("unroll") for (int r = 4; r < 16; r += 4) { a_ = ATT_MX3(a_, C0[r], C0[r + 1]); b_ = ATT_MX3(b_, C0[r + 2], C0[r + 3]); a_ = ATT_MX3(a_, C1[r], C1[r + 1]); b_ = ATT_MX3(b_, C1[r + 2], C1[r + 3]); } \
        rm = __builtin_fmaxf(a_, b_); \
        auto rr_ = __builtin_amdgcn_permlane32_swap(__float_as_uint(rm), __float_as_uint(rm), false, false); rm = __builtin_fmaxf(__uint_as_float(rr_[0]), __uint_as_float(rr_[1])); } while (0)
#define ATT_PE(P0, P1, e) ((e) < 16 ? P0[(e) & 15] : P1[(e) & 15])
#define ATT_EXPE(P0, P1, e) do { if ((e) < 16) P0[(e) & 15] = __builtin_amdgcn_exp2f(P0[(e) & 15]); else P1[(e) & 15] = __builtin_amdgcn_exp2f(P1[(e) & 15]); } while (0)
#define ATT_PACK(P0, P1, i) pw[(i) >> 2][(i) & 3] = cvtpk(ATT_PE(P0, P1, 2 * (i)), ATT_PE(P0, P1, 2 * (i) + 1))
#define ATT_KRD(d) do { kfa[d] = *(const LAS bf16x8*)(kp_ + (d) * 2048); kfb[d] = *(const LAS bf16x8*)(kp_ + (d) * 2048 + 512); } while (0)
#define ATT_VRD(i) do { vfa[i] = vtr(vp_ + ((i) & 1) * 4096 + ((i) >> 1) * 1024); vfb[i] = vtr(vp_ + ((i) & 1) * 4096 + ((i) >> 1) * 1024 + 512); } while (0)
#define ATT_STEP(C0, C1, P0, P1, t, BAND) do { \
        ATT_TOPW(t); \
        const lds_cptr kp_ = kp0 + (((t) + 1) & 3) * KSLOT; const lds_cptr vp_ = vp0 + ((t) % 3) * VSLOT; \
        float sacc = 0.f; u32x4 pw[4]; bf16x8 kfa[NKC], kfb[NKC]; s16x4 vfa[8], vfb[8]; \
        ATT_KRD(0); if (NKC > 1) ATT_KRD(1); ATT_SB(); ATT_TOPD(t); ATT_SB(); \
        _Pragma("unroll") for (int d0 = 0; d0 < NKC; ++d0) { \
            _Pragma("unroll") for (int hh = 0; hh < 2; ++hh) { const int g = 2 * d0 + hh; \
                if (hh == 0) C0 = ATT_MFMA(kfa[d0], qr[d0], d0 == 0 ? negm : C0); else C1 = ATT_MFMA(kfb[d0], qr[d0], d0 == 0 ? negm : C1); \
                if (hh == 0 && d0 + 2 < NKC) ATT_KRD(d0 + 2); \
                if (hh == 1 && d0 == NKC - 2) ATT_VRD(0); \
                if (hh == 1 && d0 == NKC - 1) ATT_VRD(1); \
                _Pragma("unroll") for (int e = (g * 32) / NCH; e < ((g + 1) * 32) / NCH; ++e) ATT_EXPE(P0, P1, e); \
                ATT_PIN(P0); ATT_PIN(P1); \
                if (g == NCH - 1) { ATT_PACK(P0, P1, 0); ATT_PACK(P0, P1, 1); ATT_PACK(P0, P1, 2); ATT_PACK(P0, P1, 3); } \
                ATT_SB(); } } \
        if (BAND) ATT_MASK(C0, C1, (t) + 1); \
        float rm; ATT_ROWMAX(C0, C1, rm); \
        bool resc = false; float fsc = 1.f; \
        if (__any(rm > THR)) { const float dl = fmaxf(rm, 0.f); mhat += dl; \
            _Pragma("unroll") for (int r = 0; r < 16; ++r) { C0[r] -= dl; C1[r] -= dl; negm[r] = -mhat; } \
            fsc = __builtin_amdgcn_exp2f(-dl); if (hi == 0) wsf[r32] = fsc; resc = true; } \
        ATT_SB(); \
        _Pragma("unroll") for (int i = 0; i < 8; ++i) { const int ks = i >> 1, dh = i & 1; \
            const bf16x8 vf = (bf16x8){vfa[i][0], vfa[i][1], vfa[i][2], vfa[i][3], vfb[i][0], vfb[i][1], vfb[i][2], vfb[i][3]}; \
            if (dh == 0) o0 = ATT_MFMA(__builtin_bit_cast(bf16x8, pw[ks]), vf, o0); else o1 = ATT_MFMA(__builtin_bit_cast(bf16x8, pw[ks]), vf, o1); \
            if (i + 2 < 8) ATT_VRD(i + 2); \
            _Pragma("unroll") for (int e = 4 * i; e < 4 * i + 4; ++e) sacc += ATT_PE(P0, P1, e); \
            ATT_PIN(sacc); \
            if (i < 6) { ATT_PACK(P0, P1, 4 + 2 * i); ATT_PACK(P0, P1, 5 + 2 * i); } \
            ATT_SB(); } \
        l_reg += sacc; \
        if (resc) { l_reg *= fsc; asm volatile("s_waitcnt lgkmcnt(0)" ::: "memory"); \
            _Pragma("unroll") for (int r = 0; r < 16; ++r) { const float a_ = wsf[crow(r, hi)]; o0[r] *= a_; o1[r] *= a_; } } \
    } while (0)
#define ATT_STEPF(C0, C1, P0, P1, t, BAND) do { \
        ATT_TOPW(t); \
        const lds_cptr kp_ = kp0 + (((t) + 1) & 3) * KSLOT; const lds_cptr vp_ = vp0 + ((t) % 3) * VSLOT; const lds_cptr kn_ = kp0 + (((t) + 2) & 3) * KSLOT; \
        u32x4 pw[4]; bf16x8 kfa[NKC], kfb[NKC]; s16x4 vfa[8], vfb[8]; const f32x16 zero_ = {}; \
        kfa[0] = nka0; kfb[0] = nkb0; kfa[1] = nka1; kfb[1] = nkb1; ATT_TOPD(t); ATT_SB(); \
        _Pragma("unroll") for (int d0 = 0; d0 < NKC; ++d0) { \
            _Pragma("unroll") for (int hh = 0; hh < 2; ++hh) { const int g = 2 * d0 + hh; \
                if (hh == 0) C0 = ATT_MFMA(kfa[d0], qr[d0], d0 == 0 ? zero_ : C0); else C1 = ATT_MFMA(kfb[d0], qr[d0], d0 == 0 ? zero_ : C1); \
                if (hh == 0 && d0 + 2 < NKC) ATT_KRD(d0 + 2); \
                if (hh == 1 && d0 == NKC - 2) ATT_VRD(0); \
                if (hh == 1 && d0 == NKC - 1) ATT_VRD(1); \
                _Pragma("unroll") for (int e = (g * 32) / NCH; e < ((g + 1) * 32) / NCH; ++e) ATT_EXPE(P0, P1, e); \
                ATT_PIN(P0); ATT_PIN(P1); \
                if (g == NCH - 1) { ATT_PACK(P0, P1, 0); ATT_PACK(P0, P1, 1); ATT_PACK(P0, P1, 2); ATT_PACK(P0, P1, 3); } \
                ATT_SB(); } } \
        _Pragma("unroll") for (int i = 0; i < 8; ++i) { const int ks = i >> 1, dh = i & 1; \
            const bf16x8 vf = (bf16x8){vfa[i][0], vfa[i][1], vfa[i][2], vfa[i][3], vfb[i][0], vfb[i][1], vfb[i][2], vfb[i][3]}; \
            if (dh == 0) o0 = ATT_MFMA(__builtin_bit_cast(bf16x8, pw[ks]), vf, o0); else o1 = ATT_MFMA(__builtin_bit_cast(bf16x8, pw[ks]), vf, o1); \
            if (i + 2 < 8) ATT_VRD(i + 2); \
            if (i & 1) lacc = __builtin_amdgcn_mfma_f32_16x16x32_bf16(__builtin_bit_cast(bf16x8, pw[ks]), selB, lacc, 0, 0, 0); \
            if (i < 6) { ATT_PACK(P0, P1, 4 + 2 * i); ATT_PACK(P0, P1, 5 + 2 * i); } \
            if (i == 4 && (t) + 2 < NT) { nka0 = *(const LAS bf16x8*)(kn_); nkb0 = *(const LAS bf16x8*)(kn_ + 512); } \
            if (i == 5 && (t) + 2 < NT) { nka1 = *(const LAS bf16x8*)(kn_ + 2048); nkb1 = *(const LAS bf16x8*)(kn_ + 2048 + 512); } \
            ATT_SB(); } \
        if (BAND) ATT_MASK(C0, C1, (t) + 1); \
    } while (0)
    ATT_NWAIT();
    ATT_DMA_K(3, 3); ATT_DMA_V(1, 1);
    bf16x8 nka0 = {}, nkb0 = {}, nka1 = {}, nkb1 = {};
    f32x4 lacc = {0.f, 0.f, 0.f, 0.f};
    const short selv_ = ((lane & 15) == (lane >> 4)) ? (short)0x3f80 : (short)0;
    const bf16x8 selB = (bf16x8){selv_, selv_, selv_, selv_, selv_, selv_, selv_, selv_};
    { const lds_cptr kp_ = kp0;
      pA0 = negm; pA1 = negm;
#pragma unroll
      for (int d0 = 0; d0 < NKC; ++d0) { const bf16x8 k0 = *(const LAS bf16x8*)(kp_ + d0 * 2048), k1 = *(const LAS bf16x8*)(kp_ + d0 * 2048 + 512);
          pA0 = ATT_MFMA(k0, qr[d0], pA0); pA1 = ATT_MFMA(k1, qr[d0], pA1); }
      ATT_MASK(pA0, pA1, 0);
      if constexpr (!FIXREF) {
          float rm; ATT_ROWMAX(pA0, pA1, rm);
          mhat = rm;
#pragma unroll
          for (int r = 0; r < 16; ++r) { pA0[r] -= rm; pA1[r] -= rm; negm[r] = -mhat; } }
      if constexpr (FIXREF) { const lds_cptr kn_ = kp0 + KSLOT; nka0 = *(const LAS bf16x8*)(kn_); nkb0 = *(const LAS bf16x8*)(kn_ + 512); nka1 = *(const LAS bf16x8*)(kn_ + 2048); nkb1 = *(const LAS bf16x8*)(kn_ + 2048 + 512); } }
    if constexpr (FIXREF) {
        if (NT > 4) {
            for (int t = 0; t + 6 < NT; t += 2) {
                ATT_STEPF(pB0, pB1, pA0, pA1, t, false);
                ATT_STEPF(pA0, pA1, pB0, pB1, t + 1, false);
            }
            ATT_STEPF(pB0, pB1, pA0, pA1, NT - 6, false);
            ATT_STEPF(pA0, pA1, pB0, pB1, NT - 5, true);
        }
        ATT_STEPF(pB0, pB1, pA0, pA1, NT - 4, true);
        ATT_STEPF(pA0, pA1, pB0, pB1, NT - 3, true);
        ATT_STEPF(pB0, pB1, pA0, pA1, NT - 2, true);
    } else {
        if (NT > 4) {
            for (int t = 0; t + 6 < NT; t += 2) {
                ATT_STEP(pB0, pB1, pA0, pA1, t, false);
                ATT_STEP(pA0, pA1, pB0, pB1, t + 1, false);
            }
            ATT_STEP(pB0, pB1, pA0, pA1, NT - 6, false);
            ATT_STEP(pA0, pA1, pB0, pB1, NT - 5, true);
        }
        ATT_STEP(pB0, pB1, pA0, pA1, NT - 4, true);
        ATT_STEP(pA0, pA1, pB0, pB1, NT - 3, true);
        ATT_STEP(pB0, pB1, pA0, pA1, NT - 2, true);
    }
    { float sacc = 0.f; u32x4 pw[4];
#pragma unroll
      for (int r = 0; r < 16; ++r) { pB0[r] = __builtin_amdgcn_exp2f(pB0[r]); pB1[r] = __builtin_amdgcn_exp2f(pB1[r]); if constexpr (!FIXREF) sacc += pB0[r] + pB1[r]; }
      l_reg += sacc;
#pragma unroll
      for (int i = 0; i < 4; ++i) { pw[0][i] = cvtpk(pB0[2 * i], pB0[2 * i + 1]); pw[1][i] = cvtpk(pB0[8 + 2 * i], pB0[8 + 2 * i + 1]); pw[2][i] = cvtpk(pB1[2 * i], pB1[2 * i + 1]); pw[3][i] = cvtpk(pB1[8 + 2 * i], pB1[8 + 2 * i + 1]); }
      const lds_cptr vp = vp0 + ((NT - 1) % 3) * VSLOT;
#pragma unroll
      for (int ks = 0; ks < 4; ++ks) {
          const s16x4 a0 = vtr(vp + ks * 1024), a1 = vtr(vp + ks * 1024 + 512), c0 = vtr(vp + 4096 + ks * 1024), c1 = vtr(vp + 4096 + ks * 1024 + 512);
          const bf16x8 vf0 = (bf16x8){a0[0], a0[1], a0[2], a0[3], a1[0], a1[1], a1[2], a1[3]};
          const bf16x8 vf1 = (bf16x8){c0[0], c0[1], c0[2], c0[3], c1[0], c1[1], c1[2], c1[3]};
          const bf16x8 pa = __builtin_bit_cast(bf16x8, pw[ks]);
          if constexpr (FIXREF) lacc = __builtin_amdgcn_mfma_f32_16x16x32_bf16(pa, selB, lacc, 0, 0, 0);
          o0 = ATT_MFMA(pa, vf0, o0); o1 = ATT_MFMA(pa, vf1, o1); } }
    if constexpr (FIXREF) {
        f32x4 lt;
#pragma unroll
        for (int j = 0; j < 4; ++j) lt[j] = lacc[j] + __shfl_down(lacc[j], 2);
        if ((lane & 15) < 2) *(LAS f32x4*)(wsf + 32 + 16 * (lane & 15) + 4 * (lane >> 4)) = lt;
    } else {
        auto rr = __builtin_amdgcn_permlane32_swap(__float_as_uint(l_reg), __float_as_uint(l_reg), false, false); l_reg = __uint_as_float(rr[0]) + __uint_as_float(rr[1]);
        if (hi == 0) wsf[32 + r32] = l_reg;
    }
    asm volatile("s_waitcnt lgkmcnt(0)" ::: "memory");
    bf16_t* Ow = O + (rowbase + q0 + wid * 32) * 1024 + h * 64;
    { LAS bf16_t* stg = (LAS bf16_t*)(shm3 + L_OST) + wid * 2048;
#pragma unroll
      for (int r = 0; r < 16; ++r) { const int orow = crow(r, hi); const float rl = __builtin_amdgcn_rcpf(wsf[32 + orow]);
          stg[orow * 64 + r32] = (bf16_t)f2bf(o0[r] * rl); stg[orow * 64 + 32 + r32] = (bf16_t)f2bf(o1[r] * rl); }
      asm volatile("s_waitcnt lgkmcnt(0)" ::: "memory");
#pragma unroll
      for (int i = 0; i < 4; ++i) { const int row = i * 8 + (lane >> 3), ch = lane & 7; const u32x4 v = *(const LAS u32x4*)(stg + row * 64 + ch * 8); *(u32x4*)(Ow + (long)row * 1024 + ch * 8) = v; } }
    asm volatile("s_waitcnt vmcnt(0) lgkmcnt(0)\n\ts_barrier" ::: "memory");
#undef ATT_DMA
#undef ATT_DMA_K
#undef ATT_DMA_V
}

template <int NKC, bool FIXREF, bool QNORM>
__device__ __forceinline__ void attn_phase_impl(unsigned char* lds, const bf16_t* Qm, const bf16_t* Qa, const bf16_t* Km, const bf16_t* V, bf16_t* O, const float* cg, float sbound, const float* gqn, const int* posp) {
    const int G = gridDim.x, bx = blockIdx.x;
    for (int i = 0;; ++i) {
        int bh, pair;
        if (G == 256) { if (i >= 4) break; bh = (bx & 7) * 4 + i; pair = bx >> 3; }
        else { const int u = i * G + bx; if (u >= NB * NH * (NQB / 2)) break; bh = u / (NQB / 2); pair = u % (NQB / 2); }
        attn_unit<NKC, FIXREF, QNORM>(bh / NH, bh % NH, NQB - 1 - pair, Qm, Qa, Km, Km, V, O, lds, cg, sbound, gqn, posp);
        attn_unit<NKC, FIXREF, QNORM>(bh / NH, bh % NH, pair, Qm, Qa, Km, Km, V, O, lds, cg, sbound, gqn, posp);
    }
}
template <int NKC, bool QNORM>
__device__ __forceinline__ void attn_phase(unsigned char* lds, const bf16_t* Qm, const bf16_t* Qa, const bf16_t* Km, const bf16_t* V, bf16_t* O, const float* gq, const float* gk, int ng, const float* cg, const int* posp) {
    float m1 = 0.f, m2 = 0.f;
    int ln_ = threadIdx.x; asm volatile("" : "+v"(ln_));
    for (int i = ln_ & 63; i < ng; i += 64) { m1 = fmaxf(m1, fabsf(gq[i])); m2 = fmaxf(m2, fabsf(gk[i])); }
#pragma unroll
    for (int o = 1; o < 64; o <<= 1) { m1 = fmaxf(m1, __shfl_xor(m1, o)); m2 = fmaxf(m2, __shfl_xor(m2, o)); }
    const float bound = sqrtf((float)ng) * m1 * m2 * LOG2E;
    if (__builtin_amdgcn_readfirstlane(__float_as_uint(bound)) < __float_as_uint(100.f)) attn_phase_impl<NKC, true, QNORM>(lds, Qm, Qa, Km, V, O, cg, bound, gq, posp);
    else attn_phase_impl<NKC, false, QNORM>(lds, Qm, Qa, Km, V, O, (const float*)nullptr, 0.f, gq, posp);
}
}


#define XB_TMO      128
#define XB_XCNT(j)  (256  + 64 * (j))
#define XB_XSUB(j)  (1280 + 64 * (j))
#define XB_XGEN(j)  (2304 + 64 * (j))
#define XB_TOP      3328
#define XB_TOPGEN   3392
#define XCD_BAR_WORDS 3456
#define XB_SPIN_CAP (1u << 20)
__device__ __forceinline__ unsigned xb_ld(unsigned* p)              { return __hip_atomic_load(p, __ATOMIC_RELAXED, __HIP_MEMORY_SCOPE_AGENT); }
__device__ __forceinline__ unsigned xb_add(unsigned* p, unsigned v) { return __hip_atomic_fetch_add(p, v, __ATOMIC_RELAXED, __HIP_MEMORY_SCOPE_AGENT); }
__device__ __forceinline__ unsigned xb_xcc_id() { return (unsigned)__builtin_amdgcn_s_getreg((3 << 11) | 20) & 0xFu; }
#define XB_SPIN(cond, bar) do { unsigned _sp = 0; while (cond) { __builtin_amdgcn_s_sleep(1); \
    if ((++_sp & 255u) == 0u) { if (xb_ld(&(bar)[XB_TMO])) break; if (_sp > XB_SPIN_CAP) { atomicAdd(&(bar)[XB_TMO], 1u); break; } } } } while (0)
struct XcdBarrier { unsigned* bar; unsigned x; volatile LAS unsigned* st; };
__device__ __forceinline__ XcdBarrier xcd_barrier_post(unsigned* bar, volatile LAS unsigned* st) {
    XcdBarrier b; b.bar = bar; b.x = xb_xcc_id(); b.st = st;
    if (threadIdx.x == 0) (void)xb_add(&bar[XB_XCNT(b.x)], 1u);
    return b;
}
__device__ __forceinline__ void xcd_barrier_complete(unsigned* bar, unsigned x, unsigned& nloc, unsigned& nx) {
    const unsigned G = gridDim.x * gridDim.y * gridDim.z;
    unsigned sum, cnt, mine, sp = 0u;
    for (;;) {
        sum = 0u; cnt = 0u; mine = 0u;
#pragma unroll
        for (unsigned j = 0; j < 16; ++j) { const unsigned c = xb_ld(&bar[XB_XCNT(j)]); sum += c; cnt += (c > 0u) ? 1u : 0u; mine = (j == x) ? c : mine; }
        if (sum == G) break;
        __builtin_amdgcn_s_sleep(1);
        if ((++sp & 255u) == 0u) { if (xb_ld(&bar[XB_TMO])) break; if (sp > XB_SPIN_CAP) { atomicAdd(&bar[XB_TMO], 1u); break; } }
    }
    nloc = mine > 0u ? mine : 1u; nx = cnt > 0u ? cnt : 1u;
}
__device__ __forceinline__ void xcd_barrier(const XcdBarrier& b) {
    asm volatile("s_waitcnt vmcnt(0)" ::: "memory");
    __syncthreads();
    if (threadIdx.x == 0) {
        unsigned* bar = b.bar;
        __builtin_amdgcn_s_waitcnt(0);
        unsigned nloc = b.st[0], nx = b.st[1];
        if (nloc == 0u) { xcd_barrier_complete(bar, b.x, nloc, nx); b.st[0] = nloc; b.st[1] = nx; }
        const unsigned old = xb_add(&bar[XB_XSUB(b.x)], 1u);
        const unsigned gen = old / nloc;
        if (old + 1u == (gen + 1u) * nloc) {
            __builtin_amdgcn_fence(__ATOMIC_RELEASE, "agent");
            asm volatile("s_waitcnt vmcnt(0)" ::: "memory");
            const unsigned og = xb_add(&bar[XB_TOP], 1u);
            const unsigned tg = og / nx;
            if (og + 1u == (tg + 1u) * nx) xb_add(&bar[XB_TOPGEN], 1u);
            else XB_SPIN(xb_ld(&bar[XB_TOPGEN]) == tg, bar);
            __builtin_amdgcn_fence(__ATOMIC_ACQUIRE, "agent");
            xb_add(&bar[XB_XGEN(b.x)], 1u);
            asm volatile("s_waitcnt vmcnt(0)" ::: "memory");
        } else {
            XB_SPIN(xb_ld(&bar[XB_XGEN(b.x)]) == gen, bar);
            __builtin_amdgcn_fence(__ATOMIC_ACQUIRE, "agent");
            asm volatile("s_waitcnt vmcnt(0)" ::: "memory");
        }
    }
    __syncthreads();
}

constexpr size_t MiB = 1u << 20;
constexpr size_t W_F1IN = 2 * MiB, W_F1OUT = W_F1IN + 22 * MiB, W_F2IN = W_F1OUT + 11 * MiB, W_F2OUT = W_F2IN + 22 * MiB;
constexpr size_t W_PG = W_F2OUT + 11 * MiB, W_PP = W_PG + 4 * MiB;
constexpr size_t W_MIN = W_PP + 1 * MiB, W_UQ = W_MIN + 2 * MiB, W_UKV = W_UQ + 2 * MiB, W_MO = W_UKV + 1 * MiB;
constexpr size_t W_FIN = W_MO + 2 * MiB, W_FO = W_FIN + 7 * MiB, W_END = W_FO + 2 * MiB;
static_assert(W_END <= 90 * MiB, "weights");
constexpr size_t WS_ST0 = 90 * MiB, WS_ST1 = 92 * MiB, WS_FLOG = 94 * MiB, WS_PB = 96 * MiB, WS_HB = 128 * MiB, WS_PP = 192 * MiB, WS_BIG = 256 * MiB, WS_NEED = 512 * MiB;
constexpr size_t WS_CG = 496 * MiB;
constexpr size_t WS_HB2 = 432 * MiB;
constexpr size_t WS_QM = WS_BIG, WS_KM = WS_BIG + 64 * MiB  , WS_V = WS_BIG + 160 * MiB  , WS_QA = WS_BIG + 224 * MiB;

enum { MAP_ID = 0, MAP_SWIGLU = 1, MAP_UQ = 2, MAP_UKV = 3, MAP_FOXIN = 4 };
__device__ __forceinline__ int col_map(int kind, int n, int Norig) {
    if (kind == MAP_SWIGLU) { const int pn = n >> 8, j = n & 255; return j < 128 ? 128 * pn + j : DFF + 128 * pn + (j - 128); }
    if (kind == MAP_UQ) { if (n < 1024) return (n >> 6) * 96 + (n & 63); const int q = n - 1024; return (q >> 5) * 96 + 64 + (q & 31); }
    if (kind == MAP_UKV) { if (n < 1024) return (n >> 6) * 128 + (n & 63); const int q = n - 1024; return (q >> 6) * 128 + 64 + (q & 63); }
    if (kind == MAP_FOXIN && n < 2048) { const int sec = n >> 10, ts = (n >> 8) & 3, j = n & 255; return sec * 1024 + (4 * ts + ((j >> 5) & 3)) * 64 + 32 * (j >> 7) + (j & 31); }
    return n < Norig ? n : -1;
}
__device__ __forceinline__ void tr_load(const float* W, int Norig, const float* g, int Npad, int kind, int item, int lane, f32x4 (&v)[8]) {
    const int nblk = Npad / 32, kb = item / nblk, nb = item % nblk, k0 = 64 * kb, n0 = 32 * nb;
    const int c4 = lane & 7, r8 = lane >> 3;
    const int oc = col_map(kind, n0 + 4 * c4, Norig);
#pragma unroll
    for (int i = 0; i < 8; ++i) { const int kk = 8 * i + r8; v[i] = (f32x4){0.f, 0.f, 0.f, 0.f};
        if (oc >= 0) { v[i] = *(const f32x4*)(W + (size_t)(k0 + kk) * Norig + oc); if (g) v[i] = v[i] * g[k0 + kk]; } }
}
__device__ __forceinline__ void tr_store(const f32x4 (&v)[8], bf16_t* WT, int K, int Npad, int item, LAS float* scr, int lane) {
    const int nblk = Npad / 32, kb = item / nblk, nb = item % nblk, k0 = 64 * kb, n0 = 32 * nb;
    const int c4 = lane & 7, r8 = lane >> 3;
#pragma unroll
    for (int i = 0; i < 8; ++i) { LAS float* d = scr + (8 * i + r8) * 33 + 4 * c4; d[0] = v[i][0]; d[1] = v[i][1]; d[2] = v[i][2]; d[3] = v[i][3]; }
    asm volatile("s_waitcnt lgkmcnt(0)" ::: "memory");
    const int c = lane & 7;
#pragma unroll
    for (int j = 0; j < 4; ++j) { const int n = (lane >> 3) + 8 * j; const LAS float* s = scr + (8 * c) * 33 + n;
        u32x4 o; o.x = pk2(s[0 * 33], s[1 * 33]); o.y = pk2(s[2 * 33], s[3 * 33]); o.z = pk2(s[4 * 33], s[5 * 33]); o.w = pk2(s[6 * 33], s[7 * 33]);
        *(u32x4*)(WT + (size_t)(n0 + n) * K + k0 + 8 * c) = o; }
    asm volatile("s_waitcnt lgkmcnt(0)" ::: "memory");
}

struct Args { const float* in[26]; float* out; unsigned char* ws; };
#ifndef REP_ATT
#define REP_ATT 1
#endif
#ifndef REP_PRO
#define REP_PRO 1
#endif
#ifndef REP_FFNIN
#define REP_FFNIN 1
#endif
#ifndef PH_MASK
#define PH_MASK 0xFFFF
#endif
#define PH(b) if constexpr ((PH_MASK >> (b)) & 1)

#define TRD(Wp, Kd, No, gp, WTp, Np, knd) if (!fnd_) { const int ni_ = ((Kd) / 64) * ((Np) / 32); if (r_ < ni_) { dW = Wp; dK = Kd; dNo = No; dg = gp; dWT = WTp; dNp = Np; dkind = knd; fnd_ = true; } else r_ -= ni_; }

__global__ void __launch_bounds__(512, 2) fwd_mega(Args a) {
    extern __shared__ __attribute__((aligned(16))) unsigned char lds[];
    cg::grid_group grid = cg::this_grid();
    LAS unsigned char* lds3 = (LAS unsigned char*)lds;
    int tid = threadIdx.x;
    const int G = gridDim.x, bx = blockIdx.x;
#define lane (tid & 63)
#define wave (__builtin_amdgcn_readfirstlane(tid >> 6))
#define gw (bx * 8 + wave)
#define NGW (G * 8)
    typedef __attribute__((address_space(4))) const Args* kargs_t;
    kargs_t ap = (kargs_t)__builtin_amdgcn_kernarg_segment_ptr();
    size_t st0_off = WS_ST0, st1_off = WS_ST1;
    volatile LAS unsigned* MISC = (volatile LAS unsigned*)(lds3 + 131072 + 320);
    if (threadIdx.x < 32) MISC[threadIdx.x] = 0u;
    __syncthreads();
    int att_grp;
    { const unsigned simd = (unsigned)__builtin_amdgcn_s_getreg((1 << 11) | (4 << 6) | 4) & 3u;
      unsigned rank = 0u; if ((threadIdx.x & 63) == 0) rank = __hip_atomic_fetch_add((LAS unsigned*)(lds3 + 131072 + 320 + 64) + simd, 1u, __ATOMIC_RELAXED, __HIP_MEMORY_SCOPE_WORKGROUP);
      att_grp = (int)(__builtin_amdgcn_readfirstlane(rank) & 1u); }
    const XcdBarrier xbar = xcd_barrier_post((unsigned*)ap->ws + 1024, MISC + 8);
#define LND() asm volatile("" : "+s"(ap), "+v"(tid))
#define ws ((unsigned char*)ap->ws)
#define out ((float*)ap->out)
#define xin ((const float*)ap->in[0])
#define pin ((const float*)ap->in[1])
#define pos ((const int*)ap->in[2])
#define AIN(i) ((const float*)ap->in[i])
#define hb ((bf16_t*)(ws + WS_HB))
#define hb2 ((bf16_t*)(ws + WS_HB2))
#define ppb ((bf16_t*)(ws + WS_PP))
#define pb ((bf16_t*)(ws + WS_PB))
#define st0 ((float*)(ws + st0_off))
#define st1 ((float*)(ws + st1_off))
#define flog ((float*)(ws + WS_FLOG))
#define cgl ((float*)(ws + WS_CG))
#define hid ((bf16_t*)(ws + WS_BIG))
#define qm ((bf16_t*)(ws + WS_QM))
#define km ((bf16_t*)(ws + WS_KM))
#define vv ((bf16_t*)(ws + WS_V))
#define qa ((bf16_t*)(ws + WS_QA))
#define zb ppb
#define ob ppb

    for (int rep_ = 0; rep_ < REP_PRO; ++rep_) { LND(); PH(0) {
        LAS float* scr = (LAS float*)(lds3 + wave * 16384);
        constexpr int NI_FIN = (1024 / 64) * (5632 / 32), NI_FOUT = (2816 / 64) * (1024 / 32), NI_G = (1024 / 64) * (1024 / 32), NI_P = (256 / 64) * (1024 / 32);
        constexpr int NI_MIN = NI_G, NI_UQ = (512 / 64) * (1536 / 32), NI_UKV = (256 / 64) * (2048 / 32), NI_FI = (1024 / 64) * (3328 / 32);
        constexpr int NITEMS = 2 * (2 * NI_FIN + 2 * NI_FOUT + NI_G + NI_P) + NI_MIN + NI_UQ + NI_UKV + NI_G + NI_FI + NI_G;
#define TR_DECODE(it_) \
        const float* dW = nullptr; const float* dg = nullptr; bf16_t* dWT = nullptr; int dK = 0, dNo = 0, dNp = 0, dkind = 0; int r_ = (it_); bool fnd_ = false; \
        for (int l = 0; l < 2; ++l) { \
            TRD(AIN(7) + (size_t)l * 1024 * 5632, 1024, 5632, AIN(3) + l * 1024, (bf16_t*)(ws + W_F1IN) + (size_t)l * 5632 * 1024, 5632, MAP_SWIGLU) \
            TRD(AIN(8) + (size_t)l * 2816 * 1024, 2816, 1024, (const float*)nullptr, (bf16_t*)(ws + W_F1OUT) + (size_t)l * 1024 * 2816, 1024, MAP_ID) \
            TRD(AIN(9) + (size_t)l * 1024 * 5632, 1024, 5632, AIN(5) + l * 1024, (bf16_t*)(ws + W_F2IN) + (size_t)l * 5632 * 1024, 5632, MAP_SWIGLU) \
            TRD(AIN(10) + (size_t)l * 2816 * 1024, 2816, 1024, (const float*)nullptr, (bf16_t*)(ws + W_F2OUT) + (size_t)l * 1024 * 2816, 1024, MAP_ID) \
            TRD(AIN(12) + (size_t)l * 1024 * 1024, 1024, 1024, AIN(6) + l * 1024, (bf16_t*)(ws + W_PG) + (size_t)l * 1024 * 1024, 1024, MAP_ID) \
            TRD(AIN(11) + (size_t)l * 256 * 1024, 256, 1024, (const float*)nullptr, (bf16_t*)(ws + W_PP) + (size_t)l * 1024 * 256, 1024, MAP_ID) \
        } \
        TRD(AIN(13), 1024, 800, AIN(4), (bf16_t*)(ws + W_MIN), 1024, MAP_ID) \
        TRD(AIN(15), 512, 1536, AIN(14), (bf16_t*)(ws + W_UQ), 1536, MAP_UQ) \
        TRD(AIN(17), 256, 2048, AIN(16), (bf16_t*)(ws + W_UKV), 2048, MAP_UKV) \
        TRD(AIN(20), 1024, 1024, (const float*)nullptr, (bf16_t*)(ws + W_MO), 1024, MAP_ID) \
        TRD(AIN(21), 1024, 3088, AIN(4) + 1024, (bf16_t*)(ws + W_FIN), 3328, MAP_FOXIN) \
        TRD(AIN(25), 1024, 1024, (const float*)nullptr, (bf16_t*)(ws + W_FO), 1024, MAP_ID)
        if (gw < NITEMS) {
            int it = gw;
            f32x4 va[8]; bf16_t* cWT; int cK, cNp, cr;
            { TR_DECODE(it) tr_load(dW, dNo, dg, dNp, dkind, r_, lane, va); cWT = dWT; cK = dK; cNp = dNp; cr = r_; }
            for (;;) {
                const int nx = it + NGW; const bool hn = nx < NITEMS;
                f32x4 vb[8]; bf16_t* nWT = cWT; int nK = cK, nNp = cNp, nr = cr;
                if (hn) { TR_DECODE(nx) tr_load(dW, dNo, dg, dNp, dkind, r_, lane, vb); nWT = dWT; nK = dK; nNp = dNp; nr = r_; }
                tr_store(va, cWT, cK, cNp, cr, scr, lane);
                if (!hn) break;
#pragma unroll
                for (int i = 0; i < 8; ++i) va[i] = vb[i];
                cWT = nWT; cK = nK; cNp = nNp; cr = nr; it = nx;
            }
        }
#undef TR_DECODE
#pragma unroll 2
        for (int m = gw; m < T; m += NGW) {
            const f32x4* xr = (const f32x4*)(xin + (size_t)m * DM) + lane; float s = 0.f;
            unsigned long long* o8 = (unsigned long long*)(hb + (size_t)m * DM) + lane;
#pragma unroll
            for (int j = 0; j < 4; ++j) { const f32x4 v = xr[64 * j]; s += (v[0] * v[0] + v[1] * v[1]) + (v[2] * v[2] + v[3] * v[3]);
                o8[64 * j] = (unsigned long long)pk2(v[0], v[1]) | ((unsigned long long)pk2(v[2], v[3]) << 32); }
#pragma unroll
            for (int o = 1; o < 64; o <<= 1) s += __shfl_xor(s, o);
            if (lane < 16) st0[(size_t)m * 16 + lane] = lane == 0 ? s : 0.f;
        }
#pragma unroll 8
        for (int m = gw; m < 2 * T; m += NGW) {
            const f32x4 v = *((const f32x4*)(pin + (size_t)m * PLE) + lane);
            *((unsigned long long*)(pb + (size_t)m * PLE) + lane) = (unsigned long long)pk2(v[0], v[1]) | ((unsigned long long)pk2(v[2], v[3]) << 32);
        }
    }
    }
    grid.sync();

    using pg8::Gemm; using pg8::StaticOrder; using pg8::RowStat; using pg8::EpiBf16; using pg8::EpiSwiGLU; using pg8::EpiRes;
    typedef EpiRes<false> EpiResN; typedef EpiRes<true> EpiResP; typedef EpiBf16<true, true, false> EpiBfMin; typedef EpiBf16<true, false, false> EpiBfUp; typedef EpiBf16<true, false, true> EpiBfFox; typedef EpiBf16<false, false, false> EpiBfPlain;
#define RUN_GEMM(EPI, ALIGN, Aptr, lda_, Bptr, Mm, Nn, Kk, E) do { int k_ = Kk, n_ = Nn, l_ = lda_; asm volatile("" : "+s"(k_), "+s"(n_), "+s"(l_)); Gemm g_{Aptr, Bptr, Mm, n_, k_, l_}; StaticOrder S_; S_.init(Mm, n_, G, bx); \
        pg8::gemm_phase<EPI, ALIGN, true>(lds3, g_, S_, E); } while (0)

#pragma unroll 1
    for (int l = 0; l < 2; ++l) {
        for (int rep_ = 0; rep_ < REP_FFNIN; ++rep_) { LND(); PH(1) { EpiSwiGLU E{hid, DFF, RowStat{st0, 0xFu, 1.f / DM}};
          RUN_GEMM(EpiSwiGLU, true, (l == 0 ? hb : hb2), DM, (const bf16_t*)(ws + W_F1IN) + (size_t)l * 5632 * 1024, T, 2 * DFF, DM, E); } }
        xcd_barrier(xbar);
        LND(); PH(2) { EpiResN E{l == 0 ? xin : (const float*)out, out, hb, st1, 0.5f, nullptr, RowStat{nullptr, 0u, 0.f}};
          RUN_GEMM(EpiResN, true, hid, DFF, (const bf16_t*)(ws + W_F1OUT) + (size_t)l * 1024 * 2816, T, DM, DFF, E); }
        xcd_barrier(xbar);
        if (l == 0) {
            LND(); PH(3) { EpiBfMin E{zb, zb, zb, DM, DM, -1, RowStat{st1, 0xFu, 1.f / DM}, st0, nullptr, nullptr, -1, nullptr, nullptr, nullptr};
              RUN_GEMM(EpiBfMin, true, hb, DM, (const bf16_t*)(ws + W_MIN), T, 1024, DM, E); }
            xcd_barrier(xbar);
            LND(); PH(10) { EpiBfUp E{qm, qa, qa, 1024, 512, -1, RowStat{st0, 0x3u, 1.f / 512}, nullptr, nullptr, nullptr, -1, nullptr, nullptr, nullptr};
              RUN_GEMM(EpiBfUp, true, zb, DM, (const bf16_t*)(ws + W_UQ), T, 1536, 512, E); }
            LND(); PH(11) { EpiBfUp E{hb, hb, vv, 1024, 1024, 1, RowStat{st0, 0x4u, 1.f / 256}, nullptr, nullptr, nullptr, -1, nullptr, nullptr, nullptr};
              RUN_GEMM(EpiBfUp, true, zb + 512, DM, (const bf16_t*)(ws + W_UKV), T, 2048, 256, E); }
            xcd_barrier(xbar);
            LND(); PH(4) {
                const float* gq = AIN(18); const float* gk = AIN(19);
                const int head = lane >> 2, part = lane & 3;
                float gqr[32], gkr[32];
#pragma unroll
                for (int i = 0; i < 32; ++i) { gqr[i] = part < 3 ? gq[part * 32 + i] : 0.f; gkr[i] = part < 3 ? gk[part * 32 + i] : 0.f; }
                const float C2 = 0.10206207261596577f * LOG2E;
                for (int m = gw; m < T; m += NGW) {
                    float cs[16], sn[16];
                    { const float pf = (float)pos[m];
#pragma unroll
                      for (int i = 0; i < 16; ++i) { const float invf = __builtin_bit_cast(float, __builtin_bit_cast(unsigned, exp2f(-(float)i * 0.8304820237218406f)));
                          const float ang = pf * invf; const double rev = (double)ang * 0.15915494309189535; const float fr = (float)(rev - __builtin_rint(rev));
                          cs[i] = __builtin_amdgcn_cosf(fr); sn[i] = __builtin_amdgcn_sinf(fr); } }
#pragma unroll
                    for (int qk = 1; qk < 2; ++qk) {
                        bf16_t* src;
                        if (qk == 0) src = part < 2 ? qm + (size_t)m * 1024 + head * 64 + part * 32 : qa + (size_t)m * 512 + head * 32;
                        else src = part < 2 ? hb + (size_t)m * 1024 + head * 64 + part * 32 : zb + (size_t)m * 1024 + 768;
                        float v[32];
                        u32x4 w[4];
#pragma unroll
                        for (int i = 0; i < 4; ++i) w[i] = part < 3 ? *(const u32x4*)(src + 8 * i) : (u32x4){0u, 0u, 0u, 0u};
                        float ss = 0.f;
#pragma unroll
                        for (int i = 0; i < 4; ++i)
#pragma unroll
                            for (int j = 0; j < 4; ++j) { v[8 * i + 2 * j] = bflo(w[i][j]); v[8 * i + 2 * j + 1] = bfhi(w[i][j]); }
#pragma unroll
                        for (int i = 0; i < 32; ++i) ss += v[i] * v[i];
                        ss += __shfl_xor(ss, 1); ss += __shfl_xor(ss, 2);
                        const float rstd = __builtin_amdgcn_rsqf(ss * (1.f / 96.f) + EPS) * (qk == 0 ? C2 : 1.f);
#pragma unroll
                        for (int i = 0; i < 32; ++i) v[i] = v[i] * rstd * (qk == 0 ? gqr[i] : gkr[i]);
                        if (part == 2) {
#pragma unroll
                            for (int i = 0; i < 16; ++i) { const float x1 = v[i], x2 = v[16 + i]; v[i] = x1 * cs[i] - x2 * sn[i]; v[16 + i] = x1 * sn[i] + x2 * cs[i]; }
                        }
                        bf16_t* dst = src; size_t dstep = 8;
                        if (qk == 1) { const int bb = m >> 14, sq = m & (SEQ - 1);
                            dst = km + ((size_t)((bb * NH + head) * (SEQ / 64) + (sq >> 6))) * (12 * 512) + (part * 4) * 512 + (sq & 63) * 8; dstep = 512; }
                        if (part < 3) {
#pragma unroll
                            for (int i = 0; i < 4; ++i) { u32x4 o; o.x = pk2(v[8 * i], v[8 * i + 1]); o.y = pk2(v[8 * i + 2], v[8 * i + 3]); o.z = pk2(v[8 * i + 4], v[8 * i + 5]); o.w = pk2(v[8 * i + 6], v[8 * i + 7]); *(u32x4*)(dst + dstep * i) = o; }
                        }
                    }
                }
            }
            xcd_barrier(xbar);
            for (int rep_ = 0; rep_ < REP_ATT; ++rep_) { LND(); PH(5) att::attn_phase<6, true>(lds, qm, qa, km, vv, ob, AIN(18), AIN(19), 96, (const float*)nullptr, pos); }
            xcd_barrier(xbar);
            LND(); PH(2) { EpiResN E{out, out, hb, st1, 1.0f, nullptr, RowStat{nullptr, 0u, 0.f}};
              RUN_GEMM(EpiResN, true, ob, DM, (const bf16_t*)(ws + W_MO), T, DM, DM, E); }
            xcd_barrier(xbar);
        } else {
            LND(); PH(6) { EpiBfFox E{qm, ppb, vv, 1024, 1024, 2, RowStat{st1, 0xFu, 1.f / DM}, nullptr, flog, AIN(22), 12, AIN(23), AIN(24), km};
              RUN_GEMM(EpiBfFox, true, hb, DM, (const bf16_t*)(ws + W_FIN), T, 3328, DM, E); }
            xcd_barrier(xbar);
            LND(); PH(7) {
                LAS double* pre = (LAS double*)lds3;
                LAS float* fl = (LAS float*)(lds3 + 16384);
                LAS float* cl = (LAS float*)(lds3 + 16384 + 8192);
                for (int ch = bx; ch < T / 128; ch += G) {
                    const int t0 = ch * 128, bstart = (t0 / SEQ) * SEQ;
                    { const int hq = tid & 3, rs = tid >> 2; double s0 = 0.0, s1 = 0.0, s2 = 0.0, s3 = 0.0;
#pragma unroll 8
                      for (int tt = bstart + rs; tt < t0; tt += 128) { const f32x4 v = *(const f32x4*)(flog + (size_t)tt * 16 + 4 * hq); s0 += (double)v[0]; s1 += (double)v[1]; s2 += (double)v[2]; s3 += (double)v[3]; }
                      pre[rs * 16 + 4 * hq + 0] = s0; pre[rs * 16 + 4 * hq + 1] = s1; pre[rs * 16 + 4 * hq + 2] = s2; pre[rs * 16 + 4 * hq + 3] = s3; }
                    { const f32x4 v = *((const f32x4*)(flog + (size_t)t0 * 16) + tid); *((LAS f32x4*)fl + tid) = v; }
                    __syncthreads();
                    if (tid < 16) { double run = 0.0; for (int s = 0; s < 128; ++s) run += pre[s * 16 + tid];
                        for (int i = 0; i < 128; ++i) { run += (double)fl[i * 16 + tid]; cl[i * 16 + tid] = (float)(run * 1.4426950408889634); } }
                    __syncthreads();
                    { const int tsub = lane >> 4, hd = lane & 15;
#pragma unroll
                      for (int it = 0; it < 4; ++it) {
                        const int tl = wave * 16 + it * 4 + tsub; const size_t m = (size_t)t0 + tl;
                        const float c = cl[tl * 16 + hd];
                        cgl[m * 16 + hd] = c;
                        const unsigned chi = f2bf(c); const float r1 = c - __builtin_bit_cast(float, chi << 16);
                        const unsigned cmi = f2bf(r1); const float r2 = r1 - __builtin_bit_cast(float, cmi << 16);
                        const unsigned clo = f2bf(r2);
                        const unsigned ONE = 0x3f80u;
                        const int bb = (int)(m >> 14), sq = (int)(m & (SEQ - 1));
                        bf16_t* kim = km + ((size_t)((bb * NH + hd) * (SEQ / 64) + (sq >> 6))) * (10 * 512) + (sq & 63) * 8;
                        bf16_t* qad = qa + m * 256 + hd * 16;
                        const u32x4 zz = (u32x4){0u, 0u, 0u, 0u};
                        u32x4 eq, ek;
                        eq.x = chi | (cmi << 16); eq.y = clo | (ONE << 16); eq.z = ONE | (ONE << 16); eq.w = 0u;
                        ek.x = ONE | (ONE << 16); ek.y = ONE | ((chi ^ 0x8000u) << 16); ek.z = (cmi ^ 0x8000u) | ((clo ^ 0x8000u) << 16); ek.w = 0u;
                        *(u32x4*)qad = eq; *(u32x4*)(qad + 8) = zz;
                        *(u32x4*)(kim + 8 * 512) = ek; *(u32x4*)(kim + 9 * 512) = zz;
                      } }
                    __syncthreads();
                }
            }
            xcd_barrier(xbar);
            for (int rep_ = 0; rep_ < REP_ATT; ++rep_) { LND(); PH(8) att::attn_phase<5, false>(lds, qm, qa, km, vv, ob, AIN(23), AIN(24), 64, cgl, pos); }
            xcd_barrier(xbar);
            LND(); PH(2) { EpiResN E{out, out, hb, st1, 1.0f, nullptr, RowStat{nullptr, 0u, 0.f}};
              RUN_GEMM(EpiResN, true, ob, DM, (const bf16_t*)(ws + W_FO), T, DM, DM, E); }
            xcd_barrier(xbar);
        }
        for (int rep_ = 0; rep_ < REP_FFNIN; ++rep_) { LND(); PH(1) { EpiSwiGLU E{hid, DFF, RowStat{st1, 0xFu, 1.f / DM}};
          RUN_GEMM(EpiSwiGLU, true, hb, DM, (const bf16_t*)(ws + W_F2IN) + (size_t)l * 5632 * 1024, T, 2 * DFF, DM, E); } }
        xcd_barrier(xbar);
        LND(); PH(2) { EpiResN E{out, out, hb, st0, 0.5f, nullptr, RowStat{nullptr, 0u, 0.f}};
          RUN_GEMM(EpiResN, true, hid, DFF, (const bf16_t*)(ws + W_F2OUT) + (size_t)l * 1024 * 2816, T, DM, DFF, E); }
        xcd_barrier(xbar);
        LND(); PH(9) { EpiBfPlain E{ppb, ppb, ppb, DM, DM, -1, RowStat{nullptr, 0u, 0.f}, nullptr, nullptr, nullptr, -1, nullptr, nullptr, nullptr};
          RUN_GEMM(EpiBfPlain, true, pb + (size_t)l * T * PLE, PLE, (const bf16_t*)(ws + W_PP) + (size_t)l * 1024 * 256, T, DM, PLE, E); }
        asm volatile("s_waitcnt vmcnt(0)" ::: "memory");
        LND(); PH(9) { EpiResP E{out, out, hb2, st1, 1.0f, ppb, RowStat{st0, 0xFu, 1.f / DM}};
          RUN_GEMM(EpiResP, true, hb, DM, (const bf16_t*)(ws + W_PG) + (size_t)l * 1024 * 1024, T, DM, DM, E); }
        if (l == 0) xcd_barrier(xbar);
        { const size_t tmp = st0_off; st0_off = st1_off; st1_off = tmp; }
    }
}

#undef ws
#undef out
#undef xin
#undef pin
#undef pos
#undef AIN
#undef hb
#undef hb2
#undef ppb
#undef pb
#undef st0
#undef st1
#undef flog
#undef cgl
#undef hid
#undef qm
#undef km
#undef vv
#undef qa
#undef zb
#undef ob
#undef LND
#undef lane
#undef wave
#undef gw
#undef NGW
constexpr int LDS_BYTES = 147456;

extern "C" void kernel_launch(void* const* d_in, const int* in_sizes, int n_in, void* d_out, int out_size, void* d_ws, size_t ws_size, hipStream_t stream) {
    static int grid = 0;
    if (grid == 0) {
        if (n_in != 26 || out_size != T * DM || ws_size < WS_NEED) { fprintf(stderr, "kernel_launch: unexpected shapes (n_in %d out %d ws %zu)\n", n_in, out_size, ws_size); grid = -1; return; }
        int dev = 0, cus = 0, per_cu = 0;
        hipGetDevice(&dev); hipDeviceGetAttribute(&cus, hipDeviceAttributeMultiprocessorCount, dev);
        if (hipFuncSetAttribute((const void*)fwd_mega, hipFuncAttributeMaxDynamicSharedMemorySize, LDS_BYTES) != hipSuccess) { fprintf(stderr, "kernel_launch: hipFuncSetAttribute failed\n"); grid = -1; return; }
        hipOccupancyMaxActiveBlocksPerMultiprocessor(&per_cu, (const void*)fwd_mega, 512, LDS_BYTES);
        if (per_cu < 1) { fprintf(stderr, "kernel_launch: occupancy query says %d\n", per_cu); per_cu = 1; }
        (void)hipGetLastError();
        grid = cus;
    }
    if (grid < 0) return;
    if (hipMemsetAsync(d_ws, 0, 65536, stream) != hipSuccess) { fprintf(stderr, "kernel_launch: memset failed\n"); return; }
    Args a{};
    for (int i = 0; i < 26; ++i) a.in[i] = (const float*)d_in[i];
    a.out = (float*)d_out; a.ws = (unsigned char*)d_ws;
    void* args[] = {&a};
    hipError_t e = hipLaunchCooperativeKernel((const void*)fwd_mega, dim3(grid), dim3(512), args, LDS_BYTES, stream);
    if (e != hipSuccess) fprintf(stderr, "cooperative launch failed: %s (grid %d)\n", hipGetErrorString(e), grid);
}
```

```cpp
#include <hip/hip_runtime.h>
#include <hip/hip_cooperative_groups.h>
#include <cstdio>
#include <cstdint>
namespace cg = cooperative_groups;

#define LAS __attribute__((address_space(3)))
typedef unsigned short bf16_t;
typedef short bf16x8 __attribute__((ext_vector_type(8)));
typedef short s16x4 __attribute__((ext_vector_type(4)));
typedef float f32x4 __attribute__((ext_vector_type(4)));
typedef float f32x16 __attribute__((ext_vector_type(16)));
typedef unsigned u32x4 __attribute__((ext_vector_type(4)));
typedef unsigned u32x2 __attribute__((ext_vector_type(2)));

constexpr int DM = 1024, SEQ = 16384, NB = 2, T = NB * SEQ, DFF = 2816, PLE = 256, NH = 16;
constexpr float EPS = 1e-6f;
constexpr float LOG2E = 1.4426950408889634f;

__device__ __forceinline__ unsigned f2bf(float f) { unsigned u = __builtin_bit_cast(unsigned, f); return (u + 0x7fffu + ((u >> 16) & 1u)) >> 16; }
typedef float f32x2v_t __attribute__((ext_vector_type(2))); typedef __bf16 bf16x2v_t __attribute__((ext_vector_type(2)));
__device__ __forceinline__ unsigned pk2(float lo, float hi) { f32x2v_t v = {lo, hi}; bf16x2v_t b = __builtin_convertvector(v, bf16x2v_t); return __builtin_bit_cast(unsigned, b); }
__device__ __forceinline__ float bf2f(unsigned short b) { return __builtin_bit_cast(float, (unsigned)b << 16); }
__device__ __forceinline__ float bflo(unsigned w) { return __builtin_bit_cast(float, w << 16); }
__device__ __forceinline__ float bfhi(unsigned w) { return __builtin_bit_cast(float, w & 0xffff0000u); }

namespace pg8 {
constexpr int BM = 256, BK = 64, HALF = 128, HTB = HALF * BK * 2, STAGE_BYTES = 8 * HTB, NXCD = 8, WGM = 8;
__host__ __device__ __forceinline__ int lds_byte(int r, int c) { const int st = (r >> 4) * 2 + (c >> 5), rr = r & 15, cc = c & 31, ob = rr * 64 + cc * 2; return st * 1024 + (ob ^ (((ob >> 9) & 1) << 5)); }
__host__ __device__ __forceinline__ void stage_rc(int b, int& R, int& C) { const int st = b / 1024, sb = b % 1024, swz = sb ^ (((sb >> 9) & 1) << 5); R = (st >> 1) * 16 + swz / 64; C = (st & 1) * 32 + (swz % 64) / 2; }
__host__ __device__ __forceinline__ int perm32(int rho) { const int n = rho >> 4, i = rho & 15; return 8 * (i >> 2) + 4 * n + (i & 3); }

struct Unit { int pm, pn; };
struct Gemm { const bf16_t* A; const bf16_t* Bt; int M, N, K, lda; };

struct StaticOrder {
    int nM, nN, nwg, G, c;
    __device__ void init(int M, int N, int G_, int c_) { nM = M / BM; nN = N / BM; nwg = nM * nN; G = G_; c = c_; }
    __device__ bool next(int i, Unit& u) const {
        const long L = (long)i * G + c; if (L >= nwg) return false;
        int wgid = (int)L; { const int q = nwg / NXCD, r = nwg % NXCD, xcd = wgid % NXCD, off = wgid / NXCD; wgid = (xcd < r ? xcd * (q + 1) : r * (q + 1) + (xcd - r) * q) + off; }
        const int nig = WGM * nN, gid = wgid / nig, fm = gid * WGM, gsz = (nM - fm) < WGM ? (nM - fm) : WGM;
        u.pm = fm + ((wgid % nig) % gsz); u.pn = (wgid % nig) / gsz; return true;
    }
};

__device__ __forceinline__ unsigned cvt_pk_bf16(float lo, float hi) { unsigned r; asm volatile("v_cvt_pk_bf16_f32 %0, %1, %2" : "=v"(r) : "v"(lo), "v"(hi)); return r; }

typedef f32x4 Acc[2][2][4][2];

struct RowStat { const float* st; unsigned mask; float invK; };
__device__ __forceinline__ void load_rstd(const RowStat& rs, int row0, int fq, float (&r)[2][4]) {
#pragma unroll
    for (int ai = 0; ai < 2; ++ai)
#pragma unroll
        for (int m = 0; m < 4; ++m) {
            const f32x4 v = *(const f32x4*)(rs.st + (size_t)(row0 + ai * HALF + m * 16) * 16 + 4 * fq);
            float s = ((rs.mask >> fq) & 1u) ? (v[0] + v[1]) + (v[2] + v[3]) : 0.f;
            s += __shfl_xor(s, 16); s += __shfl_xor(s, 32);
            r[ai][m] = __builtin_amdgcn_rsqf(s * rs.invK + EPS);
        }
}

template <bool HAS_RS, bool HAS_ST, bool HAS_FLOG> struct EpiBf16 {
    static constexpr bool PERM = true;
    bf16_t* b0; bf16_t* b1; bf16_t* bv; int ld0, ld1, vt;
    RowStat rs; float* st_out; float* flg; const float* bfv; int flog_pn;
    const float* gqp; const float* gkp; bf16_t* kimg;
    __device__ __forceinline__ void operator()(const Acc& acc, const Unit& u, int wr, int wc, int fr, int fq) const {
        const int row0 = u.pm * BM + wr * 64 + fr;
        float rstd[2][4];
        if constexpr (HAS_RS) load_rstd(rs, row0, fq, rstd);
        else {
#pragma unroll
            for (int ai = 0; ai < 2; ++ai)
#pragma unroll
                for (int m = 0; m < 4; ++m) rstd[ai][m] = 1.f; }
        if (HAS_FLOG && u.pn == flog_pn) {
            if (wc == 0 && fq < 2) {
#pragma unroll
                for (int ai = 0; ai < 2; ++ai)
#pragma unroll
                    for (int m = 0; m < 4; ++m)
#pragma unroll
                        for (int n = 0; n < 2; ++n) { const f32x4 a = acc[ai][0][m][n]; f32x4 o;
#pragma unroll
                            for (int j = 0; j < 4; ++j) { const float x = a[j] * rstd[ai][m] + bfv[8 * fq + 4 * n + j]; o[j] = fminf(x, 0.f) - log1pf(__expf(-fabsf(x))); }
                            *(f32x4*)(flg + (size_t)(row0 + ai * HALF + m * 16) * 16 + 8 * fq + 4 * n) = o; }
            }
            return;
        }
        if constexpr (HAS_FLOG) {
            if (u.pn < 8) {
                const bool isq = u.pn < 4; const int head = 4 * (u.pn & 3) + wc; const float* gp = isq ? gqp : gkp;
                f32x4 gl[2][2];
#pragma unroll
                for (int bj = 0; bj < 2; ++bj)
#pragma unroll
                    for (int n = 0; n < 2; ++n) gl[bj][n] = *(const f32x4*)(gp + 32 * bj + 8 * fq + 4 * n);
                const float qsc = isq ? 0.125f * LOG2E : 1.f;
#pragma unroll
                for (int ai = 0; ai < 2; ++ai)
#pragma unroll
                    for (int m = 0; m < 4; ++m) { const int row = row0 + ai * HALF + m * 16; const float rr = rstd[ai][m]; float ss = 0.f; f32x4 z[2][2];
#pragma unroll
                        for (int bj = 0; bj < 2; ++bj)
#pragma unroll
                            for (int n = 0; n < 2; ++n) { z[bj][n] = acc[ai][bj][m][n] * rr; ss += (z[bj][n][0] * z[bj][n][0] + z[bj][n][1] * z[bj][n][1]) + (z[bj][n][2] * z[bj][n][2] + z[bj][n][3] * z[bj][n][3]); }
                        ss += __shfl_xor(ss, 16); ss += __shfl_xor(ss, 32);
                        const float rh = __builtin_amdgcn_rsqf(ss * (1.f / 64.f) + EPS) * qsc;
                        const int bb = row >> 14, sq = row & (SEQ - 1);
#pragma unroll
                        for (int bj = 0; bj < 2; ++bj) { const f32x4 v0 = z[bj][0] * rh * gl[bj][0], v1 = z[bj][1] * rh * gl[bj][1];
                            u32x4 w; w.x = cvt_pk_bf16(v0[0], v0[1]); w.y = cvt_pk_bf16(v0[2], v0[3]); w.z = cvt_pk_bf16(v1[0], v1[1]); w.w = cvt_pk_bf16(v1[2], v1[3]);
                            bf16_t* dst = isq ? b0 + (size_t)row * 1024 + head * 64 + 32 * bj + 8 * fq
                                              : kimg + ((size_t)((bb * NH + head) * (SEQ / 64) + (sq >> 6))) * (10 * 512) + (4 * bj + fq) * 512 + (sq & 63) * 8;
                            *(u32x4*)dst = w; } }
                return;
            }
        }
        const int t = u.pn >> 2; const bool isv = (t == vt); bf16_t* base = t == 0 ? b0 : b1; const int ldc = t == 0 ? ld0 : ld1;
        const int col0 = (u.pn & 3) * BM + wc * 32 + 8 * fq;
#pragma unroll
        for (int ai = 0; ai < 2; ++ai)
#pragma unroll
            for (int m = 0; m < 4; ++m) { const int row = row0 + ai * HALF + m * 16; const float rr = rstd[ai][m]; float ss = 0.f;
                bf16_t* rowp;
                if (isv) {
                    const int bb = row >> 14, sq = row & (SEQ - 1);
                    rowp = bv + ((size_t)((bb * NH + (col0 >> 6)) * (SEQ / 64) + (sq >> 6))) * 4096 + ((col0 >> 5) & 1) * 2048 + (sq & 63) * 32 + (col0 & 31);
                } else rowp = base + (size_t)row * ldc + col0;
                const size_t bjstep = isv ? (size_t)2 * (SEQ / 64) * 4096 : (size_t)HALF;
#pragma unroll
                for (int bj = 0; bj < 2; ++bj) { const f32x4 v0 = acc[ai][bj][m][0] * rr, v1 = acc[ai][bj][m][1] * rr;
                    ss += (v0[0] * v0[0] + v0[1] * v0[1]) + (v0[2] * v0[2] + v0[3] * v0[3]) + (v1[0] * v1[0] + v1[1] * v1[1]) + (v1[2] * v1[2] + v1[3] * v1[3]);
                    u32x4 w; w.x = cvt_pk_bf16(v0[0], v0[1]); w.y = cvt_pk_bf16(v0[2], v0[3]); w.z = cvt_pk_bf16(v1[0], v1[1]); w.w = cvt_pk_bf16(v1[2], v1[3]);
                    *(u32x4*)(rowp + bj * bjstep) = w; }
                if constexpr (HAS_ST) { ss += __shfl_xor(ss, 16); ss += __shfl_xor(ss, 32); if (fq == 0) st_out[(size_t)row * 16 + ((u.pn * 4 + wc) & 15)] = ss; } }
    }
};

struct EpiSwiGLU {
    static constexpr bool PERM = true;
    bf16_t* O; int ldc; RowStat rs;
    __device__ __forceinline__ void operator()(const Acc& acc, const Unit& u, int wr, int wc, int fr, int fq) const {
        const int row0 = u.pm * BM + wr * 64 + fr;
        float rstd[2][4]; load_rstd(rs, row0, fq, rstd);
        const int col0 = u.pn * HALF + wc * 32 + 8 * fq;
#pragma unroll
        for (int ai = 0; ai < 2; ++ai)
#pragma unroll
            for (int m = 0; m < 4; ++m) { const float rr = rstd[ai][m]; float o[8];
#pragma unroll
                for (int n = 0; n < 2; ++n)
#pragma unroll
                    for (int j = 0; j < 4; ++j) { const float g = acc[ai][0][m][n][j] * rr, up = acc[ai][1][m][n][j] * rr;
                        o[4 * n + j] = g * __builtin_amdgcn_rcpf(1.f + __builtin_amdgcn_exp2f(-g * LOG2E)) * up; }
                u32x4 w; w.x = cvt_pk_bf16(o[0], o[1]); w.y = cvt_pk_bf16(o[2], o[3]); w.z = cvt_pk_bf16(o[4], o[5]); w.w = cvt_pk_bf16(o[6], o[7]);
                *(u32x4*)(O + (size_t)(row0 + ai * HALF + m * 16) * ldc + col0) = w; }
    }
};

template <bool IS_PLE> struct EpiRes {
    static constexpr bool PERM = true;
    const float* base; float* out; bf16_t* hb; float* st_out; float alpha; const bf16_t* pp; RowStat rs;
    __device__ __forceinline__ void operator()(const Acc& acc, const Unit& u, int wr, int wc, int fr, int fq) const {
        const int row0 = u.pm * BM + wr * 64 + fr;
        float rstd[2][4];
        if constexpr (IS_PLE) load_rstd(rs, row0, fq, rstd);
        const int col0 = u.pn * BM + wc * 32 + 8 * fq;
#pragma unroll
        for (int ai = 0; ai < 2; ++ai)
#pragma unroll
            for (int m = 0; m < 4; ++m) { const int row = row0 + ai * HALF + m * 16; const size_t off = (size_t)row * DM + col0; float ss = 0.f;
#pragma unroll
                for (int bj = 0; bj < 2; ++bj) {
                    const f32x4 h0 = *(const f32x4*)(base + off + bj * HALF), h1 = *(const f32x4*)(base + off + bj * HALF + 4);
                    f32x4 v0, v1;
                    if constexpr (IS_PLE) { const u32x4 pw = *(const u32x4*)(pp + off + bj * HALF); const float rr = rstd[ai][m] * LOG2E;
                        const f32x4 a0 = acc[ai][bj][m][0] * rr, a1 = acc[ai][bj][m][1] * rr;
                        f32x4 s0, s1;
#pragma unroll
                        for (int j = 0; j < 4; ++j) { s0[j] = __builtin_amdgcn_rcpf(1.f + __builtin_amdgcn_exp2f(-a0[j])); s1[j] = __builtin_amdgcn_rcpf(1.f + __builtin_amdgcn_exp2f(-a1[j])); }
                        v0 = h0 + s0 * (f32x4){bflo(pw.x), bfhi(pw.x), bflo(pw.y), bfhi(pw.y)};
                        v1 = h1 + s1 * (f32x4){bflo(pw.z), bfhi(pw.z), bflo(pw.w), bfhi(pw.w)};
                    } else { v0 = h0 + acc[ai][bj][m][0] * alpha; v1 = h1 + acc[ai][bj][m][1] * alpha; }
                    *(f32x4*)(out + off + bj * HALF) = v0; *(f32x4*)(out + off + bj * HALF + 4) = v1;
                    ss += (v0[0] * v0[0] + v0[1] * v0[1]) + (v0[2] * v0[2] + v0[3] * v0[3]) + (v1[0] * v1[0] + v1[1] * v1[1]) + (v1[2] * v1[2] + v1[3] * v1[3]);
                    u32x4 w; w.x = cvt_pk_bf16(v0[0], v0[1]); w.y = cvt_pk_bf16(v0[2], v0[3]); w.z = cvt_pk_bf16(v1[0], v1[1]); w.w = cvt_pk_bf16(v1[2], v1[3]);
                    *(u32x4*)(hb + off + bj * HALF) = w; }
                ss += __shfl_xor(ss, 16); ss += __shfl_xor(ss, 32); if (fq == 0) st_out[(size_t)row * 16 + u.pn * 4 + wc] = ss;
                if (m & 1) asm volatile("" ::: "memory"); }
    }
};

template <class Epi, bool ALIGN_EPI, bool SP2>
__device__ __forceinline__ void gemm_phase(LAS unsigned char* lds, const Gemm g, const StaticOrder& S, const Epi& E) {
    int tid_ = threadIdx.x; asm volatile("" : "+v"(tid_));
    const int tid = tid_, wid = __builtin_amdgcn_readfirstlane(tid >> 6), lane = tid & 63, wr = wid >> 2, wc = wid & 3, fr = lane & 15, fq = lane >> 4;
    const int K = g.K, nt = K / BK, lda = g.lda;
    unsigned voffA[2], voffB[2];
#pragma unroll
    for (int i = 0; i < 2; ++i) { int R, C; stage_rc(tid * 16 + i * 8192, R, C); const int Rb = Epi::PERM ? ((R & ~31) + perm32(R & 31)) : R;
        voffA[i] = (unsigned)(R * lda + C) * 2u; voffB[i] = (unsigned)(Rb * K + C) * 2u; }
    const size_t kstep = (size_t)(BK * 2);
    const size_t hstepA = (size_t)HALF * lda * 2, hstepB = (size_t)HALF * K * 2;
    const size_t tstepA = 2 * hstepA, tstepB = 2 * hstepB;
    const unsigned ldsw = (unsigned)wid * 1024u;
    const int aoff = lds_byte(wr * 64 + fr, fq * 8), boff = lds_byte(wc * 32 + fr, fq * 8);
#define PG8_SA(b, h) (((b) * 2 + (h)) * HTB)
#define PG8_SB(b, h) ((4 + (b) * 2 + (h)) * HTB)
#define PG8_STAGE(bufoff, gbase, voff) do { _Pragma("unroll") for (int _i = 0; _i < 2; ++_i) \
        __builtin_amdgcn_global_load_lds((const unsigned*)((const char*)(gbase) + (voff)[_i]), (LAS unsigned*)(lds + (bufoff) + ldsw + _i * 8192), 16, 0, 0); } while (0)
#define PG8_LDA(dst, b, h) do { _Pragma("unroll") for (int m = 0; m < 4; ++m) _Pragma("unroll") for (int k = 0; k < 2; ++k) dst[m][k] = *(const LAS bf16x8*)(lds + PG8_SA(b, h) + aoff + m * 2048 + k * 1024); } while (0)
#define PG8_LDB(dst, b, h) do { _Pragma("unroll") for (int n = 0; n < 2; ++n) _Pragma("unroll") for (int k = 0; k < 2; ++k) dst[n][k] = *(const LAS bf16x8*)(lds + PG8_SB(b, h) + boff + n * 2048 + k * 1024); } while (0)
#define PG8_MMA(ai, bj, At, Bt) do { __builtin_amdgcn_s_setprio(1); _Pragma("unroll") for (int m = 0; m < 4; ++m) _Pragma("unroll") for (int n = 0; n < 2; ++n) _Pragma("unroll") for (int k = 0; k < 2; ++k) \
        acc[ai][bj][m][n] = __builtin_amdgcn_mfma_f32_16x16x32_bf16(Bt[n][k], At[m][k], acc[ai][bj][m][n], 0, 0, 0); __builtin_amdgcn_s_setprio(0); } while (0)
#define PG8_WAIT_V(n) asm volatile("s_waitcnt vmcnt(" #n ")" ::: "memory")
#define PG8_WAIT_L(n) asm volatile("s_waitcnt lgkmcnt(" #n ")" ::: "memory")
#define PG8_BAR __builtin_amdgcn_s_barrier()
#define PG8_SCHED __builtin_amdgcn_sched_barrier(0)
    Unit cur, nxt; int ui = 0;
    if (!S.next(0, cur)) return;
    Acc acc;
#pragma unroll
    for (int a = 0; a < 2; ++a)
#pragma unroll
        for (int b = 0; b < 2; ++b)
#pragma unroll
            for (int m = 0; m < 4; ++m)
#pragma unroll
                for (int n = 0; n < 2; ++n) acc[a][b][m][n] = (f32x4){0.f, 0.f, 0.f, 0.f};
    bf16x8 At[4][2], B0[2][2], B1[2][2];
    const char* cA = (const char*)g.A + (size_t)cur.pm * tstepA; const char* cB = (const char*)g.Bt + (size_t)cur.pn * tstepB;
    if constexpr (SP2) {
        PG8_STAGE(PG8_SB(0, 0), cB, voffB); PG8_STAGE(PG8_SB(0, 1), cB + hstepB, voffB); PG8_STAGE(PG8_SA(0, 0), cA, voffA); PG8_STAGE(PG8_SA(0, 1), cA + hstepA, voffA);
        if (wr == 1) PG8_BAR;
        PG8_WAIT_V(2); PG8_BAR;
        PG8_STAGE(PG8_SB(1, 0), cB + kstep, voffB); PG8_STAGE(PG8_SA(1, 0), cA + kstep, voffA); PG8_STAGE(PG8_SB(1, 1), cB + hstepB + kstep, voffB);
        PG8_WAIT_V(6); PG8_BAR;
    } else {
        PG8_STAGE(PG8_SB(0, 0), cB, voffB); PG8_STAGE(PG8_SA(0, 0), cA, voffA); PG8_STAGE(PG8_SB(0, 1), cB + hstepB, voffB); PG8_STAGE(PG8_SA(0, 1), cA + hstepA, voffA);
        if (wr == 1) PG8_BAR;
        PG8_WAIT_V(4); PG8_BAR;
        PG8_STAGE(PG8_SB(1, 0), cB + kstep, voffB); PG8_STAGE(PG8_SA(1, 0), cA + kstep, voffA); PG8_STAGE(PG8_SB(1, 1), cB + hstepB + kstep, voffB);
        PG8_WAIT_V(6); PG8_BAR;
    }
    for (;;) {
        const bool has_next = S.next(ui + 1, nxt);
        const char* nA = has_next ? (const char*)g.A + (size_t)nxt.pm * tstepA : cA; const char* nB = has_next ? (const char*)g.Bt + (size_t)nxt.pn * tstepB : cB;
        for (int t = 0; t < nt; t += 2) {
            const bool last = (t == nt - 2);
            const char* a1 = cA + (size_t)(t + 1) * kstep;
            const char* a2 = last ? nA : cA + (size_t)(t + 2) * kstep; const char* b2 = last ? nB : cB + (size_t)(t + 2) * kstep;
            const char* a3 = a2 + kstep; const char* b3 = b2 + kstep;
            if constexpr (SP2) {
            PG8_LDB(B0, 0, 0); PG8_LDB(B1, 0, 1); PG8_SCHED; PG8_LDA(At, 0, 0); PG8_STAGE(PG8_SA(1, 1), a1 + hstepA, voffA);
            PG8_WAIT_V(8); PG8_WAIT_L(0); PG8_BAR; PG8_MMA(0, 0, At, B0); PG8_MMA(0, 1, At, B1); PG8_BAR; PG8_SCHED;
            PG8_LDA(At, 0, 1); PG8_STAGE(PG8_SB(0, 0), b2, voffB); PG8_STAGE(PG8_SB(0, 1), b2 + hstepB, voffB); PG8_STAGE(PG8_SA(0, 0), a2, voffA);
            PG8_WAIT_V(8); PG8_WAIT_L(0); PG8_BAR; PG8_MMA(1, 0, At, B0); PG8_MMA(1, 1, At, B1); PG8_BAR; PG8_SCHED;
            PG8_LDB(B0, 1, 0); PG8_LDB(B1, 1, 1); PG8_SCHED; PG8_LDA(At, 1, 0); PG8_STAGE(PG8_SA(0, 1), a2 + hstepA, voffA);
            PG8_WAIT_V(8); PG8_WAIT_L(0); PG8_BAR; PG8_MMA(0, 0, At, B0); PG8_MMA(0, 1, At, B1); PG8_BAR; PG8_SCHED;
            PG8_LDA(At, 1, 1); PG8_STAGE(PG8_SB(1, 0), b3, voffB); PG8_STAGE(PG8_SB(1, 1), b3 + hstepB, voffB); PG8_STAGE(PG8_SA(1, 0), a3, voffA);
            PG8_WAIT_V(8); PG8_WAIT_L(0); PG8_BAR; PG8_MMA(1, 0, At, B0); PG8_MMA(1, 1, At, B1); PG8_BAR; PG8_SCHED;
            } else {
            PG8_LDB(B0, 0, 0); PG8_SCHED; PG8_LDA(At, 0, 0); PG8_STAGE(PG8_SA(1, 1), a1 + hstepA, voffA);
            PG8_WAIT_L(8); PG8_BAR; PG8_WAIT_L(0); PG8_MMA(0, 0, At, B0); PG8_BAR; PG8_SCHED;
            PG8_LDB(B1, 0, 1); PG8_STAGE(PG8_SB(0, 0), b2, voffB);
            PG8_BAR; PG8_WAIT_L(0); PG8_MMA(0, 1, At, B1); PG8_BAR;
            PG8_LDA(At, 0, 1); PG8_STAGE(PG8_SA(0, 0), a2, voffA);
            PG8_BAR; PG8_WAIT_L(0); PG8_MMA(1, 0, At, B0); PG8_BAR; PG8_SCHED;
            PG8_STAGE(PG8_SB(0, 1), b2 + hstepB, voffB);
            PG8_WAIT_V(6); PG8_BAR; PG8_MMA(1, 1, At, B1); PG8_BAR;
            PG8_LDB(B0, 1, 0); PG8_SCHED; PG8_LDA(At, 1, 0); PG8_STAGE(PG8_SA(0, 1), a2 + hstepA, voffA);
            PG8_WAIT_L(8); PG8_BAR; PG8_WAIT_L(0); PG8_MMA(0, 0, At, B0); PG8_BAR; PG8_SCHED;
            PG8_LDB(B1, 1, 1); PG8_STAGE(PG8_SB(1, 0), b3, voffB);
            PG8_BAR; PG8_WAIT_L(0); PG8_MMA(0, 1, At, B1); PG8_BAR;
            PG8_LDA(At, 1, 1); PG8_STAGE(PG8_SA(1, 0), a3, voffA);
            PG8_BAR; PG8_WAIT_L(0); PG8_MMA(1, 0, At, B0); PG8_BAR; PG8_SCHED;
            PG8_STAGE(PG8_SB(1, 1), b3 + hstepB, voffB);
            PG8_WAIT_V(6); PG8_BAR; PG8_MMA(1, 1, At, B1); PG8_BAR;
            }
        }
        if constexpr (ALIGN_EPI) { if (wr == 0) PG8_BAR; }
        E(acc, cur, wr, wc, fr, fq);
        if (!has_next) break;
#pragma unroll
        for (int a = 0; a < 2; ++a)
#pragma unroll
            for (int b = 0; b < 2; ++b)
#pragma unroll
                for (int m = 0; m < 4; ++m)
#pragma unroll
                    for (int n = 0; n < 2; ++n) acc[a][b][m][n] = (f32x4){0.f, 0.f, 0.f, 0.f};
        cur = nxt; cA = nA; cB = nB; ++ui;
        if constexpr (ALIGN_EPI) { if (wr == 1) PG8_BAR; }
    }
    PG8_WAIT_V(0);
    if constexpr (!ALIGN_EPI) { if (wr == 0) PG8_BAR; }
    PG8_BAR;
#undef PG8_SA
#undef PG8_SB
#undef PG8_STAGE
#undef PG8_LDA
#undef PG8_LDB
#undef PG8_MMA
#undef PG8_WAIT_V
#undef PG8_WAIT_L
#undef PG8_BAR
#undef PG8_SCHED
}
}

namespace att {
constexpr int NQB = SEQ / 256, VSLOT = 8192;
constexpr int L_K = 0, L_V = 4 * 12288  , L_WS = L_V + 3 * VSLOT, L_OST = L_WS + 2048, L_BYTES = L_OST + 8 * 4096;
constexpr float THR = 8.f;
__device__ __forceinline__ int crow(int r, int hi) { return (r & 3) + 8 * (r >> 2) + 4 * hi; }
__device__ __forceinline__ void glds16(const void* gsrc, unsigned lds_dst) { unsigned keep;
    asm volatile("s_mov_b32 %0, m0\n\ts_mov_b32 m0, %2\n\ts_nop 0\n\tglobal_load_lds_dwordx4 %1, off\n\ts_mov_b32 m0, %0" : "=&s"(keep) : "v"(gsrc), "s"(lds_dst) : "memory"); }
__device__ __forceinline__ void glds16s(const void* sbase, unsigned voff, unsigned lds_dst) { unsigned keep;
    asm volatile("s_mov_b32 %0, m0\n\ts_mov_b32 m0, %3\n\ts_nop 0\n\tglobal_load_lds_dwordx4 %1, %2\n\ts_mov_b32 m0, %0" : "=&s"(keep) : "v"(voff), "s"(sbase), "s"(lds_dst) : "memory"); }
typedef short v4i16_t __attribute__((ext_vector_type(4)));
typedef LAS const char* lds_cptr;
__device__ __forceinline__ s16x4 vtr(lds_cptr p) { return __builtin_bit_cast(s16x4, __builtin_amdgcn_ds_read_tr16_b64_v4i16((LAS v4i16_t*)p)); }
typedef float f32x2_t __attribute__((ext_vector_type(2))); typedef __bf16 bf16x2_t __attribute__((ext_vector_type(2)));
__device__ __forceinline__ unsigned cvtpk(float lo, float hi) { f32x2_t v = {lo, hi}; bf16x2_t b = __builtin_convertvector(v, bf16x2_t); return __builtin_bit_cast(unsigned, b); }
#ifndef ATT_EXP_H1
#define ATT_EXP_H1 0
#endif
#define ATT_WAIT_BAR(N) asm volatile("s_waitcnt vmcnt(" #N ") lgkmcnt(0)\n\ts_barrier" ::: "memory")

template <int NKC, bool FIXREF, bool QNORM>
__device__ __forceinline__ void attn_unit(int b, int h, int qb, const bf16_t* Qm, const bf16_t* Qa, const bf16_t* Km, const bf16_t* Ka, const bf16_t* V, bf16_t* O, unsigned char* shm, const float* cg, float sbound, const float* gqn, const int* posp) {
    constexpr int AUGW = 16 * NKC - 64, NCH = 2 * NKC, KSLOT = NCH * 1024, NX = NCH - 8, APITCH = 16 * AUGW;
    int tid_ = threadIdx.x; asm volatile("" : "+v"(tid_));
    const int tid = tid_, lane = tid & 63, r32 = lane & 31, hi = lane >> 5; const int wid = __builtin_amdgcn_readfirstlane(tid >> 6);
    const long rowbase = (long)b * SEQ; const int q0 = qb * 256;
    int T0 = 0;
    if (cg) { const float cq0 = cg[((size_t)rowbase + q0) * 16 + h]; bool skp = false;
        if (lane < qb) { const float ck = cg[((size_t)rowbase + 256 * lane + 255) * 16 + h]; skp = (cq0 - ck) < -(2.f * sbound + 75.f); }
        T0 = 4 * (int)__popcll(__ballot(skp)); }
    const int NT = (q0 + 256) / 64 - T0;
    const unsigned lds0 = (unsigned)(uintptr_t)shm;
    LAS unsigned char* shm3 = (LAS unsigned char*)shm;
    LAS float* wsf = (LAS float*)(shm3 + L_WS) + wid * 64;
    const bf16_t* ksrc0 = Km + (size_t)(b * NH + h) * (SEQ / 64) * (KSLOT / 2) + wid * 512;
    const bf16_t* ksrc1 = ksrc0 + 8 * 512;
    const bf16_t* vsrc = V + (size_t)(b * NH + h) * (SEQ / 64) * 4096 + wid * 512;
    const unsigned dvoff = (unsigned)lane * 16u;
    const unsigned kdst0 = lds0 + L_K + wid * 1024, kdst1 = lds0 + L_K + (8 + wid) * 1024, vdst = lds0 + L_V + wid * 1024;
#define ATT_DMA_K(t, s) do { glds16s(ksrc0 + (long)(T0 + (t)) * (KSLOT / 2), dvoff, (unsigned)__builtin_amdgcn_readfirstlane(kdst0 + (s) * KSLOT)); \
        if (wid < NX) glds16s(ksrc1 + (long)(T0 + (t)) * (KSLOT / 2), dvoff, (unsigned)__builtin_amdgcn_readfirstlane(kdst1 + (s) * KSLOT)); } while (0)
#define ATT_DMA_V(t, s) glds16s(vsrc + (long)(T0 + (t)) * 4096, dvoff, (unsigned)__builtin_amdgcn_readfirstlane(vdst + (s) * VSLOT))
#define ATT_DMA(t, s) do { ATT_DMA_K(t, s); ATT_DMA_V(t, s); } while (0)
    ATT_DMA_K(0, 0);
    bf16x8 qr[NKC];
    { const bf16_t* Qrow = Qm + (rowbase + q0 + wid * 32 + r32) * 1024 + h * 64 + hi * 8;
      const bf16_t* Qarow = Qa + (rowbase + q0 + wid * 32 + r32) * APITCH + h * AUGW + hi * 8;
#pragma unroll
      for (int d0 = 0; d0 < 4; ++d0) qr[d0] = *(const bf16x8*)(Qrow + d0 * 16);
#pragma unroll
      for (int d0 = 4; d0 < NKC; ++d0) qr[d0] = *(const bf16x8*)(Qarow + (d0 - 4) * 16); }
    ATT_DMA_K(1, 1); ATT_DMA_K(2, 2); ATT_DMA_V(0, 0);
    if constexpr (QNORM) {
        static_assert(!QNORM || NKC == 6, "QNORM is the MLA (96-dim) form");
        float v[NKC][8]; float ss = 0.f;
#pragma unroll
        for (int d0 = 0; d0 < NKC; ++d0)
#pragma unroll
            for (int j = 0; j < 4; ++j) { const unsigned w = (unsigned)(unsigned short)qr[d0][2 * j] | ((unsigned)(unsigned short)qr[d0][2 * j + 1] << 16); v[d0][2 * j] = bflo(w); v[d0][2 * j + 1] = bfhi(w); }
#pragma unroll
        for (int d0 = 0; d0 < NKC; ++d0)
#pragma unroll
            for (int j = 0; j < 8; ++j) ss += v[d0][j] * v[d0][j];
        { auto rr = __builtin_amdgcn_permlane32_swap(__float_as_uint(ss), __float_as_uint(ss), false, false); ss = __uint_as_float(rr[0]) + __uint_as_float(rr[1]); }
        const float rq = __builtin_amdgcn_rsqf(ss * (1.f / 96.f) + EPS) * (0.10206207261596577f * LOG2E);
#pragma unroll
        for (int d0 = 0; d0 < NKC; ++d0) { const f32x4 g0 = *(const f32x4*)(gqn + 16 * d0 + 8 * hi), g1 = *(const f32x4*)(gqn + 16 * d0 + 8 * hi + 4);
#pragma unroll
            for (int j = 0; j < 4; ++j) { v[d0][j] *= rq * g0[j]; v[d0][4 + j] *= rq * g1[j]; } }
        const float pf = (float)posp[rowbase + q0 + wid * 32 + r32];
#pragma unroll
        for (int j = 0; j < 8; ++j) { const float invf = exp2f(-(float)(8 * hi + j) * 0.8304820237218406f);
            const float ang = pf * invf; const double rev = (double)ang * 0.15915494309189535; const float fr = (float)(rev - __builtin_rint(rev));
            const float cs = __builtin_amdgcn_cosf(fr), sn = __builtin_amdgcn_sinf(fr);
            const float x1 = v[4][j], x2 = v[5][j]; v[4][j] = x1 * cs - x2 * sn; v[5][j] = x1 * sn + x2 * cs; }
#pragma unroll
        for (int d0 = 0; d0 < NKC; ++d0) { u32x4 w; w.x = cvtpk(v[d0][0], v[d0][1]); w.y = cvtpk(v[d0][2], v[d0][3]); w.z = cvtpk(v[d0][4], v[d0][5]); w.w = cvtpk(v[d0][6], v[d0][7]); qr[d0] = __builtin_bit_cast(bf16x8, w); }
    }
    const lds_cptr kp0 = (lds_cptr)shm3 + L_K + hi * 1024 + r32 * 16;
    const lds_cptr vp0 = (lds_cptr)shm3 + L_V + ((lane >> 4) & 1) * 32 + (lane & 3) * 8 + (4 * hi + ((lane & 15) >> 2)) * 64;
    float mhat = 0.f, l_reg = 0.f; f32x16 o0 = {}, o1 = {}; f32x16 negm = {};
    f32x16 pA0, pA1, pB0, pB1;
    const int qrel = wid * 32 + r32;
#define ATT_SB() __builtin_amdgcn_sched_barrier(0)
#define ATT_PIN(x) asm volatile("" : "+v"(x))
#define ATT_MFMA(a, b, c) __builtin_amdgcn_mfma_f32_32x32x16_bf16(a, b, c, 0, 0, 0)
#define ATT_NWAIT() do { if (wid < NX) ATT_WAIT_BAR(3); else ATT_WAIT_BAR(2); } while (0)
#define ATT_TOPW(t) do { if ((t) + 3 < NT) ATT_NWAIT(); else ATT_WAIT_BAR(0); } while (0)
#define ATT_TOPD(t) do { if ((t) + 4 < NT) ATT_DMA_K((t) + 4, (t) & 3); if ((t) + 2 < NT) ATT_DMA_V((t) + 2, ((t) + 2) % 3); } while (0)
#define ATT_MASK(C0, C1, tt) do { const int jb_ = (tt) - (NT - 4); if (jb_ >= 0) { const int kb_ = 64 * jb_ + 4 * hi; \
        _Pragma("unroll") for (int r = 0; r < 16; ++r) { const int kv = kb_ + (r & 3) + 8 * (r >> 2); if (kv > qrel) C0[r] = -INFINITY; if (kv + 32 > qrel) C1[r] = -INFINITY; } } } while (0)
#define ATT_MX3(a, b, c) __builtin_fmaxf(__builtin_fmaxf((a), (b)), (c))
#define ATT_ROWMAX(C0, C1, rm) do { float a_ = ATT_MX3(C0[0], C0[1], C1[0]), b_ = ATT_MX3(C0[2], C0[3], C1[1]); a_ = ATT_MX3(a_, C1[2], C1[3]); \
        _Pragma("unroll") for (int r = 4; r < 16; r += 4) { a_ = ATT_MX3(a_, C0[r], C0[r + 1]); b_ = ATT_MX3(b_, C0[r + 2], C0[r + 3]); a_ = ATT_MX3(a_, C1[r], C1[r + 1]); b_ = ATT_MX3(b_, C1[r + 2], C1[r + 3]); } \
        rm = __builtin_fmaxf(a_, b_); \
        auto rr_ = __builtin_amdgcn_permlane32_swap(__float_as_uint(rm), __float_as_uint(rm), false, false); rm = __builtin_fmaxf(__uint_as_float(rr_[0]), __uint_as_float(rr_[1])); } while (0)
#define ATT_PE(P0, P1, e) ((e) < 16 ? P0[(e) & 15] : P1[(e) & 15])
#define ATT_EXPE(P0, P1, e) do { if ((e) < 16) P0[(e) & 15] = __builtin_amdgcn_exp2f(P0[(e) & 15]); else P1[(e) & 15] = __builtin_amdgcn_exp2f(P1[(e) & 15]); } while (0)
#define ATT_PACK(P0, P1, i) pw[(i) >> 2][(i) & 3] = cvtpk(ATT_PE(P0, P1, 2 * (i)), ATT_PE(P0, P1, 2 * (i) + 1))
#define ATT_KRD(d) do { kfa[d] = *(const LAS bf16x8*)(kp_ + (d) * 2048); kfb[d] = *(const LAS bf16x8*)(kp_ + (d) * 2048 + 512); } while (0)
#define ATT_VRD(i) do { vfa[i] = vtr(vp_ + ((i) & 1) * 4096 + ((i) >> 1) * 1024); vfb[i] = vtr(vp_ + ((i) & 1) * 4096 + ((i) >> 1) * 1024 + 512); } while (0)
#define ATT_STEP(C0, C1, P0, P1, t, BAND) do { \
        ATT_TOPW(t); \
        const lds_cptr kp_ = kp0 + (((t) + 1) & 3) * KSLOT; const lds_cptr vp_ = vp0 + ((t) % 3) * VSLOT; \
        float sacc = 0.f; u32x4 pw[4]; bf16x8 kfa[NKC], kfb[NKC]; s16x4 vfa[8], vfb[8]; \
        ATT_KRD(0); if (NKC > 1) ATT_KRD(1); ATT_SB(); ATT_TOPD(t); ATT_SB(); \
        _Pragma("unroll") for (int d0 = 0; d0 < NKC; ++d0) { \
            _Pragma("unroll") for (int hh = 0; hh < 2; ++hh) { const int g = 2 * d0 + hh; \
                if (hh == 0) C0 = ATT_MFMA(kfa[d0], qr[d0], d0 == 0 ? negm : C0); else C1 = ATT_MFMA(kfb[d0], qr[d0], d0 == 0 ? negm : C1); \
                if (hh == 0 && d0 + 2 < NKC) ATT_KRD(d0 + 2); \
                if (hh == 1 && d0 == NKC - 2) ATT_VRD(0); \
                if (hh == 1 && d0 == NKC - 1) ATT_VRD(1); \
                _Pragma("unroll") for (int e = (g * 32) / NCH; e < ((g + 1) * 32) / NCH; ++e) ATT_EXPE(P0, P1, e); \
                ATT_PIN(P0); ATT_PIN(P1); \
                if (g == NCH - 1) { ATT_PACK(P0, P1, 0); ATT_PACK(P0, P1, 1); ATT_PACK(P0, P1, 2); ATT_PACK(P0, P1, 3); } \
                ATT_SB(); } } \
        if (BAND) ATT_MASK(C0, C1, (t) + 1); \
        float rm; ATT_ROWMAX(C0, C1, rm); \
        bool resc = false; float fsc = 1.f; \
        if (__any(rm > THR)) { const float dl = fmaxf(rm, 0.f); mhat += dl; \
            _Pragma("unroll") for (int r = 0; r < 16; ++r) { C0[r] -= dl; C1[r] -= dl; negm[r] = -mhat; } \
            fsc = __builtin_amdgcn_exp2f(-dl); if (hi == 0) wsf[r32] = fsc; resc = true; } \
        ATT_SB(); \
        _Pragma("unroll") for (int i = 0; i < 8; ++i) { const int ks = i >> 1, dh = i & 1; \
            const bf16x8 vf = (bf16x8){vfa[i][0], vfa[i][1], vfa[i][2], vfa[i][3], vfb[i][0], vfb[i][1], vfb[i][2], vfb[i][3]}; \
            if (dh == 0) o0 = ATT_MFMA(__builtin_bit_cast(bf16x8, pw[ks]), vf, o0); else o1 = ATT_MFMA(__builtin_bit_cast(bf16x8, pw[ks]), vf, o1); \
            if (i + 2 < 8) ATT_VRD(i + 2); \
            _Pragma("unroll") for (int e = 4 * i; e < 4 * i + 4; ++e) sacc += ATT_PE(P0, P1, e); \
            ATT_PIN(sacc); \
            if (i < 6) { ATT_PACK(P0, P1, 4 + 2 * i); ATT_PACK(P0, P1, 5 + 2 * i); } \
            ATT_SB(); } \
        l_reg += sacc; \
        if (resc) { l_reg *= fsc; asm volatile("s_waitcnt lgkmcnt(0)" ::: "memory"); \
            _Pragma("unroll") for (int r = 0; r < 16; ++r) { const float a_ = wsf[crow(r, hi)]; o0[r] *= a_; o1[r] *= a_; } } \
    } while (0)
#define ATT_STEPF(C0, C1, P0, P1, t, BAND) do { \
        ATT_TOPW(t); \
        const lds_cptr kp_ = kp0 + (((t) + 1) & 3) * KSLOT; const lds_cptr vp_ = vp0 + ((t) % 3) * VSLOT; const lds_cptr kn_ = kp0 + (((t) + 2) & 3) * KSLOT; \
        u32x4 pw[4]; bf16x8 kfa[NKC], kfb[NKC]; s16x4 vfa[8], vfb[8]; const f32x16 zero_ = {}; \
        kfa[0] = nka0; kfb[0] = nkb0; kfa[1] = nka1; kfb[1] = nkb1; \
        _Pragma("unroll") for (int d0 = 0; d0 < NKC; ++d0) { \
            _Pragma("unroll") for (int hh = 0; hh < 2; ++hh) { const int g = 2 * d0 + hh; \
                if (hh == 0) C0 = ATT_MFMA(kfa[d0], qr[d0], d0 == 0 ? zero_ : C0); else C1 = ATT_MFMA(kfb[d0], qr[d0], d0 == 0 ? zero_ : C1); \
                if (hh == 0 && d0 + 2 < NKC) ATT_KRD(d0 + 2); \
                if (hh == 1 && d0 == NKC - 2) ATT_VRD(0); \
                if (hh == 1 && d0 == NKC - 1) ATT_VRD(1); \
                _Pragma("unroll") for (int e = (g * 32) / NCH; e < ((g + 1) * 32) / NCH; ++e) ATT_EXPE(P0, P1, e); \
                ATT_PIN(P0); ATT_PIN(P1); \
                if (g == NCH - 1) { ATT_PACK(P0, P1, 0); ATT_PACK(P0, P1, 1); ATT_PACK(P0, P1, 2); ATT_PACK(P0, P1, 3); } \
                ATT_SB(); } } \
        _Pragma("unroll") for (int i = 0; i < 8; ++i) { const int ks = i >> 1, dh = i & 1; \
            const bf16x8 vf = (bf16x8){vfa[i][0], vfa[i][1], vfa[i][2], vfa[i][3], vfb[i][0], vfb[i][1], vfb[i][2], vfb[i][3]}; \
            if (dh == 0) o0 = ATT_MFMA(__builtin_bit_cast(bf16x8, pw[ks]), vf, o0); else o1 = ATT_MFMA(__builtin_bit_cast(bf16x8, pw[ks]), vf, o1); \
            if (i + 2 < 8) ATT_VRD(i + 2); \
            if (i & 1) lacc = __builtin_amdgcn_mfma_f32_16x16x32_bf16(__builtin_bit_cast(bf16x8, pw[ks]), selB, lacc, 0, 0, 0); \
            if (i < 6) { ATT_PACK(P0, P1, 4 + 2 * i); ATT_PACK(P0, P1, 5 + 2 * i); } \
            if (i == 6) { if ((t) + 4 < NT) ATT_DMA_K((t) + 4, (t) & 3); } \
            if (i == 7) { if ((t) + 2 < NT) ATT_DMA_V((t) + 2, ((t) + 2) % 3); } \
            if (i == 4 && (t) + 2 < NT) { nka0 = *(const LAS bf16x8*)(kn_); nkb0 = *(const LAS bf16x8*)(kn_ + 512); } \
            if (i == 5 && (t) + 2 < NT) { nka1 = *(const LAS bf16x8*)(kn_ + 2048); nkb1 = *(const LAS bf16x8*)(kn_ + 2048 + 512); } \
            ATT_SB(); } \
        if (BAND) ATT_MASK(C0, C1, (t) + 1); \
    } while (0)
    ATT_NWAIT();
    ATT_DMA_K(3, 3); ATT_DMA_V(1, 1);
    bf16x8 nka0 = {}, nkb0 = {}, nka1 = {}, nkb1 = {};
    f32x4 lacc = {0.f, 0.f, 0.f, 0.f};
    const short selv_ = ((lane & 15) == (lane >> 4)) ? (short)0x3f80 : (short)0;
    const bf16x8 selB = (bf16x8){selv_, selv_, selv_, selv_, selv_, selv_, selv_, selv_};
    { const lds_cptr kp_ = kp0;
      pA0 = negm; pA1 = negm;
#pragma unroll
      for (int d0 = 0; d0 < NKC; ++d0) { const bf16x8 k0 = *(const LAS bf16x8*)(kp_ + d0 * 2048), k1 = *(const LAS bf16x8*)(kp_ + d0 * 2048 + 512);
          pA0 = ATT_MFMA(k0, qr[d0], pA0); pA1 = ATT_MFMA(k1, qr[d0], pA1); }
      ATT_MASK(pA0, pA1, 0);
      if constexpr (!FIXREF) {
          float rm; ATT_ROWMAX(pA0, pA1, rm);
          mhat = rm;
#pragma unroll
          for (int r = 0; r < 16; ++r) { pA0[r] -= rm; pA1[r] -= rm; negm[r] = -mhat; } }
      if constexpr (FIXREF) { const lds_cptr kn_ = kp0 + KSLOT; nka0 = *(const LAS bf16x8*)(kn_); nkb0 = *(const LAS bf16x8*)(kn_ + 512); nka1 = *(const LAS bf16x8*)(kn_ + 2048); nkb1 = *(const LAS bf16x8*)(kn_ + 2048 + 512); } }
    if constexpr (FIXREF) {
        if (NT > 4) {
            for (int t = 0; t + 6 < NT; t += 2) {
                ATT_STEPF(pB0, pB1, pA0, pA1, t, false);
                ATT_STEPF(pA0, pA1, pB0, pB1, t + 1, false);
            }
            ATT_STEPF(pB0, pB1, pA0, pA1, NT - 6, false);
            ATT_STEPF(pA0, pA1, pB0, pB1, NT - 5, true);
        }
        ATT_STEPF(pB0, pB1, pA0, pA1, NT - 4, true);
        ATT_STEPF(pA0, pA1, pB0, pB1, NT - 3, true);
        ATT_STEPF(pB0, pB1, pA0, pA1, NT - 2, true);
    } else {
        if (NT > 4) {
            for (int t = 0; t + 6 < NT; t += 2) {
                ATT_STEP(pB0, pB1, pA0, pA1, t, false);
                ATT_STEP(pA0, pA1, pB0, pB1, t + 1, false);
            }
            ATT_STEP(pB0, pB1, pA0, pA1, NT - 6, false);
            ATT_STEP(pA0, pA1, pB0, pB1, NT - 5, true);
        }
        ATT_STEP(pB0, pB1, pA0, pA1, NT - 4, true);
        ATT_STEP(pA0, pA1, pB0, pB1, NT - 3, true);
        ATT_STEP(pB0, pB1, pA0, pA1, NT - 2, true);
    }
    { float sacc = 0.f; u32x4 pw[4];
#pragma unroll
      for (int r = 0; r < 16; ++r) { pB0[r] = __builtin_amdgcn_exp2f(pB0[r]); pB1[r] = __builtin_amdgcn_exp2f(pB1[r]); if constexpr (!FIXREF) sacc += pB0[r] + pB1[r]; }
      l_reg += sacc;
#pragma unroll
      for (int i = 0; i < 4; ++i) { pw[0][i] = cvtpk(pB0[2 * i], pB0[2 * i + 1]); pw[1][i] = cvtpk(pB0[8 + 2 * i], pB0[8 + 2 * i + 1]); pw[2][i] = cvtpk(pB1[2 * i], pB1[2 * i + 1]); pw[3][i] = cvtpk(pB1[8 + 2 * i], pB1[8 + 2 * i + 1]); }
      const lds_cptr vp = vp0 + ((NT - 1) % 3) * VSLOT;
#pragma unroll
      for (int ks = 0; ks < 4; ++ks) {
          const s16x4 a0 = vtr(vp + ks * 1024), a1 = vtr(vp + ks * 1024 + 512), c0 = vtr(vp + 4096 + ks * 1024), c1 = vtr(vp + 4096 + ks * 1024 + 512);
          const bf16x8 vf0 = (bf16x8){a0[0], a0[1], a0[2], a0[3], a1[0], a1[1], a1[2], a1[3]};
          const bf16x8 vf1 = (bf16x8){c0[0], c0[1], c0[2], c0[3], c1[0], c1[1], c1[2], c1[3]};
          const bf16x8 pa = __builtin_bit_cast(bf16x8, pw[ks]);
          if constexpr (FIXREF) lacc = __builtin_amdgcn_mfma_f32_16x16x32_bf16(pa, selB, lacc, 0, 0, 0);
          o0 = ATT_MFMA(pa, vf0, o0); o1 = ATT_MFMA(pa, vf1, o1); } }
    if constexpr (FIXREF) {
        f32x4 lt;
#pragma unroll
        for (int j = 0; j < 4; ++j) lt[j] = lacc[j] + __shfl_down(lacc[j], 2);
        if ((lane & 15) < 2) *(LAS f32x4*)(wsf + 32 + 16 * (lane & 15) + 4 * (lane >> 4)) = lt;
    } else {
        auto rr = __builtin_amdgcn_permlane32_swap(__float_as_uint(l_reg), __float_as_uint(l_reg), false, false); l_reg = __uint_as_float(rr[0]) + __uint_as_float(rr[1]);
        if (hi == 0) wsf[32 + r32] = l_reg;
    }
    asm volatile("s_waitcnt lgkmcnt(0)" ::: "memory");
    bf16_t* Ow = O + (rowbase + q0 + wid * 32) * 1024 + h * 64;
    { LAS bf16_t* stg = (LAS bf16_t*)(shm3 + L_OST) + wid * 2048;
#pragma unroll
      for (int r = 0; r < 16; ++r) { const int orow = crow(r, hi); const float rl = __builtin_amdgcn_rcpf(wsf[32 + orow]);
          stg[orow * 64 + r32] = (bf16_t)f2bf(o0[r] * rl); stg[orow * 64 + 32 + r32] = (bf16_t)f2bf(o1[r] * rl); }
      asm volatile("s_waitcnt lgkmcnt(0)" ::: "memory");
#pragma unroll
      for (int i = 0; i < 4; ++i) { const int row = i * 8 + (lane >> 3), ch = lane & 7; const u32x4 v = *(const LAS u32x4*)(stg + row * 64 + ch * 8); *(u32x4*)(Ow + (long)row * 1024 + ch * 8) = v; } }
    asm volatile("s_waitcnt vmcnt(0) lgkmcnt(0)\n\ts_barrier" ::: "memory");
#undef ATT_DMA
#undef ATT_DMA_K
#undef ATT_DMA_V
}

template <int NKC, bool FIXREF, bool QNORM>
__device__ __forceinline__ void attn_phase_impl(unsigned char* lds, const bf16_t* Qm, const bf16_t* Qa, const bf16_t* Km, const bf16_t* V, bf16_t* O, const float* cg, float sbound, const float* gqn, const int* posp) {
    const int G = gridDim.x, bx = blockIdx.x;
    for (int i = 0;; ++i) {
        int bh, pair;
        if (G == 256) { if (i >= 4) break; bh = (bx & 7) * 4 + i; pair = bx >> 3; }
        else { const int u = i * G + bx; if (u >= NB * NH * (NQB / 2)) break; bh = u / (NQB / 2); pair = u % (NQB / 2); }
        attn_unit<NKC, FIXREF, QNORM>(bh / NH, bh % NH, NQB - 1 - pair, Qm, Qa, Km, Km, V, O, lds, cg, sbound, gqn, posp);
        attn_unit<NKC, FIXREF, QNORM>(bh / NH, bh % NH, pair, Qm, Qa, Km, Km, V, O, lds, cg, sbound, gqn, posp);
    }
}
template <int NKC, bool QNORM>
__device__ __forceinline__ void attn_phase(unsigned char* lds, const bf16_t* Qm, const bf16_t* Qa, const bf16_t* Km, const bf16_t* V, bf16_t* O, const float* gq, const float* gk, int ng, const float* cg, const int* posp) {
    float m1 = 0.f, m2 = 0.f;
    int ln_ = threadIdx.x; asm volatile("" : "+v"(ln_));
    for (int i = ln_ & 63; i < ng; i += 64) { m1 = fmaxf(m1, fabsf(gq[i])); m2 = fmaxf(m2, fabsf(gk[i])); }
#pragma unroll
    for (int o = 1; o < 64; o <<= 1) { m1 = fmaxf(m1, __shfl_xor(m1, o)); m2 = fmaxf(m2, __shfl_xor(m2, o)); }
    const float bound = sqrtf((float)ng) * m1 * m2 * LOG2E;
    if (__builtin_amdgcn_readfirstlane(__float_as_uint(bound)) < __float_as_uint(100.f)) attn_phase_impl<NKC, true, QNORM>(lds, Qm, Qa, Km, V, O, cg, bound, gq, posp);
    else attn_phase_impl<NKC, false, QNORM>(lds, Qm, Qa, Km, V, O, (const float*)nullptr, 0.f, gq, posp);
}
}


#define XB_TMO      128
#define XB_XCNT(j)  (256  + 64 * (j))
#define XB_XSUB(j)  (1280 + 64 * (j))
#define XB_XGEN(j)  (2304 + 64 * (j))
#define XB_TOP      3328
#define XB_TOPGEN   3392
#define XCD_BAR_WORDS 3456
#define XB_SPIN_CAP (1u << 20)
__device__ __forceinline__ unsigned xb_ld(unsigned* p)              { return __hip_atomic_load(p, __ATOMIC_RELAXED, __HIP_MEMORY_SCOPE_AGENT); }
__device__ __forceinline__ unsigned xb_add(unsigned* p, unsigned v) { return __hip_atomic_fetch_add(p, v, __ATOMIC_RELAXED, __HIP_MEMORY_SCOPE_AGENT); }
__device__ __forceinline__ unsigned xb_xcc_id() { return (unsigned)__builtin_amdgcn_s_getreg((3 << 11) | 20) & 0xFu; }
#define XB_SPIN(cond, bar) do { unsigned _sp = 0; while (cond) { __builtin_amdgcn_s_sleep(1); \
    if ((++_sp & 255u) == 0u) { if (xb_ld(&(bar)[XB_TMO])) break; if (_sp > XB_SPIN_CAP) { atomicAdd(&(bar)[XB_TMO], 1u); break; } } } } while (0)
struct XcdBarrier { unsigned* bar; unsigned x; volatile LAS unsigned* st; };
__device__ __forceinline__ XcdBarrier xcd_barrier_post(unsigned* bar, volatile LAS unsigned* st) {
    XcdBarrier b; b.bar = bar; b.x = xb_xcc_id(); b.st = st;
    if (threadIdx.x == 0) (void)xb_add(&bar[XB_XCNT(b.x)], 1u);
    return b;
}
__device__ __forceinline__ void xcd_barrier_complete(unsigned* bar, unsigned x, unsigned& nloc, unsigned& nx) {
    const unsigned G = gridDim.x * gridDim.y * gridDim.z;
    unsigned sum, cnt, mine, sp = 0u;
    for (;;) {
        sum = 0u; cnt = 0u; mine = 0u;
#pragma unroll
        for (unsigned j = 0; j < 16; ++j) { const unsigned c = xb_ld(&bar[XB_XCNT(j)]); sum += c; cnt += (c > 0u) ? 1u : 0u; mine = (j == x) ? c : mine; }
        if (sum == G) break;
        __builtin_amdgcn_s_sleep(1);
        if ((++sp & 255u) == 0u) { if (xb_ld(&bar[XB_TMO])) break; if (sp > XB_SPIN_CAP) { atomicAdd(&bar[XB_TMO], 1u); break; } }
    }
    nloc = mine > 0u ? mine : 1u; nx = cnt > 0u ? cnt : 1u;
}
__device__ __forceinline__ void xcd_barrier(const XcdBarrier& b) {
    asm volatile("s_waitcnt vmcnt(0)" ::: "memory");
    __syncthreads();
    if (threadIdx.x == 0) {
        unsigned* bar = b.bar;
        __builtin_amdgcn_s_waitcnt(0);
        unsigned nloc = b.st[0], nx = b.st[1];
        if (nloc == 0u) { xcd_barrier_complete(bar, b.x, nloc, nx); b.st[0] = nloc; b.st[1] = nx; }
        const unsigned old = xb_add(&bar[XB_XSUB(b.x)], 1u);
        const unsigned gen = old / nloc;
        if (old + 1u == (gen + 1u) * nloc) {
            __builtin_amdgcn_fence(__ATOMIC_RELEASE, "agent");
            asm volatile("s_waitcnt vmcnt(0)" ::: "memory");
            const unsigned og = xb_add(&bar[XB_TOP], 1u);
            const unsigned tg = og / nx;
            if (og + 1u == (tg + 1u) * nx) xb_add(&bar[XB_TOPGEN], 1u);
            else XB_SPIN(xb_ld(&bar[XB_TOPGEN]) == tg, bar);
            __builtin_amdgcn_fence(__ATOMIC_ACQUIRE, "agent");
            xb_add(&bar[XB_XGEN(b.x)], 1u);
            asm volatile("s_waitcnt vmcnt(0)" ::: "memory");
        } else {
            XB_SPIN(xb_ld(&bar[XB_XGEN(b.x)]) == gen, bar);
            __builtin_amdgcn_fence(__ATOMIC_ACQUIRE, "agent");
            asm volatile("s_waitcnt vmcnt(0)" ::: "memory");
        }
    }
    __syncthreads();
}

constexpr size_t MiB = 1u << 20;
constexpr size_t W_F1IN = 2 * MiB, W_F1OUT = W_F1IN + 22 * MiB, W_F2IN = W_F1OUT + 11 * MiB, W_F2OUT = W_F2IN + 22 * MiB;
constexpr size_t W_PG = W_F2OUT + 11 * MiB, W_PP = W_PG + 4 * MiB;
constexpr size_t W_MIN = W_PP + 1 * MiB, W_UQ = W_MIN + 2 * MiB, W_UKV = W_UQ + 2 * MiB, W_MO = W_UKV + 1 * MiB;
constexpr size_t W_FIN = W_MO + 2 * MiB, W_FO = W_FIN + 7 * MiB, W_END = W_FO + 2 * MiB;
static_assert(W_END <= 90 * MiB, "weights");
constexpr size_t WS_ST0 = 90 * MiB, WS_ST1 = 92 * MiB, WS_FLOG = 94 * MiB, WS_PB = 96 * MiB, WS_HB = 128 * MiB, WS_PP = 192 * MiB, WS_BIG = 256 * MiB, WS_NEED = 512 * MiB;
constexpr size_t WS_CG = 496 * MiB;
constexpr size_t WS_HB2 = 432 * MiB;
constexpr size_t WS_QM = WS_BIG, WS_KM = WS_BIG + 64 * MiB  , WS_V = WS_BIG + 160 * MiB  , WS_QA = WS_BIG + 224 * MiB;

enum { MAP_ID = 0, MAP_SWIGLU = 1, MAP_UQ = 2, MAP_UKV = 3, MAP_FOXIN = 4 };
__device__ __forceinline__ int col_map(int kind, int n, int Norig) {
    if (kind == MAP_SWIGLU) { const int pn = n >> 8, j = n & 255; return j < 128 ? 128 * pn + j : DFF + 128 * pn + (j - 128); }
    if (kind == MAP_UQ) { if (n < 1024) return (n >> 6) * 96 + (n & 63); const int q = n - 1024; return (q >> 5) * 96 + 64 + (q & 31); }
    if (kind == MAP_UKV) { if (n < 1024) return (n >> 6) * 128 + (n & 63); const int q = n - 1024; return (q >> 6) * 128 + 64 + (q & 63); }
    if (kind == MAP_FOXIN && n < 2048) { const int sec = n >> 10, ts = (n >> 8) & 3, j = n & 255; return sec * 1024 + (4 * ts + ((j >> 5) & 3)) * 64 + 32 * (j >> 7) + (j & 31); }
    return n < Norig ? n : -1;
}
__device__ __forceinline__ void transpose_item(const float* W, int K, int Norig, const float* g, bf16_t* WT, int Npad, int kind, LAS float* scr, int item, int lane) {
    const int nblk = Npad / 32, kb = item / nblk, nb = item % nblk, k0 = 64 * kb, n0 = 32 * nb;
    const int c4 = lane & 7, r8 = lane >> 3;
    const int oc = col_map(kind, n0 + 4 * c4, Norig);
#pragma unroll
    for (int i = 0; i < 8; ++i) { const int kk = 8 * i + r8; f32x4 v = {0.f, 0.f, 0.f, 0.f};
        if (oc >= 0) { v = *(const f32x4*)(W + (size_t)(k0 + kk) * Norig + oc); if (g) v = v * g[k0 + kk]; }
        LAS float* d = scr + kk * 33 + 4 * c4; d[0] = v[0]; d[1] = v[1]; d[2] = v[2]; d[3] = v[3]; }
    asm volatile("s_waitcnt lgkmcnt(0)" ::: "memory");
    const int c = lane & 7;
#pragma unroll
    for (int j = 0; j < 4; ++j) { const int n = (lane >> 3) + 8 * j; const LAS float* s = scr + (8 * c) * 33 + n;
        u32x4 o; o.x = pk2(s[0 * 33], s[1 * 33]); o.y = pk2(s[2 * 33], s[3 * 33]); o.z = pk2(s[4 * 33], s[5 * 33]); o.w = pk2(s[6 * 33], s[7 * 33]);
        *(u32x4*)(WT + (size_t)(n0 + n) * K + k0 + 8 * c) = o; }
    asm volatile("s_waitcnt lgkmcnt(0)" ::: "memory");
}

struct Args { const float* in[26]; float* out; unsigned char* ws; };
#ifndef REP_ATT
#define REP_ATT 1
#endif
#ifndef REP_PRO
#define REP_PRO 1
#endif
#ifndef REP_FFNIN
#define REP_FFNIN 1
#endif
#ifndef PH_MASK
#define PH_MASK 0xFFFF
#endif
#define PH(b) if constexpr ((PH_MASK >> (b)) & 1)

#define TR(Wp, Kd, No, gp, WTp, Np, kind) do { const int ni_ = ((Kd) / 64) * ((Np) / 32); if (r < ni_) { transpose_item(Wp, Kd, No, gp, WTp, Np, kind, scr, r, lane); goto next_item; } r -= ni_; } while (0)

__global__ void __launch_bounds__(512, 2) fwd_mega(Args a) {
    extern __shared__ __attribute__((aligned(16))) unsigned char lds[];
    cg::grid_group grid = cg::this_grid();
    LAS unsigned char* lds3 = (LAS unsigned char*)lds;
    int tid = threadIdx.x;
    const int G = gridDim.x, bx = blockIdx.x;
#define lane (tid & 63)
#define wave (__builtin_amdgcn_readfirstlane(tid >> 6))
#define gw (bx * 8 + wave)
#define NGW (G * 8)
    typedef __attribute__((address_space(4))) const Args* kargs_t;
    kargs_t ap = (kargs_t)__builtin_amdgcn_kernarg_segment_ptr();
    size_t st0_off = WS_ST0, st1_off = WS_ST1;
    volatile LAS unsigned* MISC = (volatile LAS unsigned*)(lds3 + 131072 + 320);
    if (threadIdx.x < 32) MISC[threadIdx.x] = 0u;
    __syncthreads();
    int att_grp;
    { const unsigned simd = (unsigned)__builtin_amdgcn_s_getreg((1 << 11) | (4 << 6) | 4) & 3u;
      unsigned rank = 0u; if ((threadIdx.x & 63) == 0) rank = __hip_atomic_fetch_add((LAS unsigned*)(lds3 + 131072 + 320 + 64) + simd, 1u, __ATOMIC_RELAXED, __HIP_MEMORY_SCOPE_WORKGROUP);
      att_grp = (int)(__builtin_amdgcn_readfirstlane(rank) & 1u); }
    const XcdBarrier xbar = xcd_barrier_post((unsigned*)ap->ws + 1024, MISC + 8);
#define LND() asm volatile("" : "+s"(ap), "+v"(tid))
#define ws ((unsigned char*)ap->ws)
#define out ((float*)ap->out)
#define xin ((const float*)ap->in[0])
#define pin ((const float*)ap->in[1])
#define pos ((const int*)ap->in[2])
#define AIN(i) ((const float*)ap->in[i])
#define hb ((bf16_t*)(ws + WS_HB))
#define hb2 ((bf16_t*)(ws + WS_HB2))
#define ppb ((bf16_t*)(ws + WS_PP))
#define pb ((bf16_t*)(ws + WS_PB))
#define st0 ((float*)(ws + st0_off))
#define st1 ((float*)(ws + st1_off))
#define flog ((float*)(ws + WS_FLOG))
#define cgl ((float*)(ws + WS_CG))
#define hid ((bf16_t*)(ws + WS_BIG))
#define qm ((bf16_t*)(ws + WS_QM))
#define km ((bf16_t*)(ws + WS_KM))
#define vv ((bf16_t*)(ws + WS_V))
#define qa ((bf16_t*)(ws + WS_QA))
#define zb ppb
#define ob ppb

    for (int rep_ = 0; rep_ < REP_PRO; ++rep_) { LND(); PH(0) {
        LAS float* scr = (LAS float*)(lds3 + wave * 16384);
        constexpr int NI_FIN = (1024 / 64) * (5632 / 32), NI_FOUT = (2816 / 64) * (1024 / 32), NI_G = (1024 / 64) * (1024 / 32), NI_P = (256 / 64) * (1024 / 32);
        constexpr int NI_MIN = NI_G, NI_UQ = (512 / 64) * (1536 / 32), NI_UKV = (256 / 64) * (2048 / 32), NI_FI = (1024 / 64) * (3328 / 32);
        constexpr int NITEMS = 2 * (2 * NI_FIN + 2 * NI_FOUT + NI_G + NI_P) + NI_MIN + NI_UQ + NI_UKV + NI_G + NI_FI + NI_G;
        for (int it = gw; it < NITEMS; it += NGW) {
            int r = it;
            for (int l = 0; l < 2; ++l) {
                TR(AIN(7) + (size_t)l * 1024 * 5632, 1024, 5632, AIN(3) + l * 1024, (bf16_t*)(ws + W_F1IN) + (size_t)l * 5632 * 1024, 5632, MAP_SWIGLU);
                TR(AIN(8) + (size_t)l * 2816 * 1024, 2816, 1024, (const float*)nullptr, (bf16_t*)(ws + W_F1OUT) + (size_t)l * 1024 * 2816, 1024, MAP_ID);
                TR(AIN(9) + (size_t)l * 1024 * 5632, 1024, 5632, AIN(5) + l * 1024, (bf16_t*)(ws + W_F2IN) + (size_t)l * 5632 * 1024, 5632, MAP_SWIGLU);
                TR(AIN(10) + (size_t)l * 2816 * 1024, 2816, 1024, (const float*)nullptr, (bf16_t*)(ws + W_F2OUT) + (size_t)l * 1024 * 2816, 1024, MAP_ID);
                TR(AIN(12) + (size_t)l * 1024 * 1024, 1024, 1024, AIN(6) + l * 1024, (bf16_t*)(ws + W_PG) + (size_t)l * 1024 * 1024, 1024, MAP_ID);
                TR(AIN(11) + (size_t)l * 256 * 1024, 256, 1024, (const float*)nullptr, (bf16_t*)(ws + W_PP) + (size_t)l * 1024 * 256, 1024, MAP_ID);
            }
            TR(AIN(13), 1024, 800, AIN(4), (bf16_t*)(ws + W_MIN), 1024, MAP_ID);
            TR(AIN(15), 512, 1536, AIN(14), (bf16_t*)(ws + W_UQ), 1536, MAP_UQ);
            TR(AIN(17), 256, 2048, AIN(16), (bf16_t*)(ws + W_UKV), 2048, MAP_UKV);
            TR(AIN(20), 1024, 1024, (const float*)nullptr, (bf16_t*)(ws + W_MO), 1024, MAP_ID);
            TR(AIN(21), 1024, 3088, AIN(4) + 1024, (bf16_t*)(ws + W_FIN), 3328, MAP_FOXIN);
            TR(AIN(25), 1024, 1024, (const float*)nullptr, (bf16_t*)(ws + W_FO), 1024, MAP_ID);
            next_item:;
        }
#pragma unroll 2
        for (int m = gw; m < T; m += NGW) {
            const f32x4* xr = (const f32x4*)(xin + (size_t)m * DM) + lane; float s = 0.f;
            unsigned long long* o8 = (unsigned long long*)(hb + (size_t)m * DM) + lane;
#pragma unroll
            for (int j = 0; j < 4; ++j) { const f32x4 v = xr[64 * j]; s += (v[0] * v[0] + v[1] * v[1]) + (v[2] * v[2] + v[3] * v[3]);
                o8[64 * j] = (unsigned long long)pk2(v[0], v[1]) | ((unsigned long long)pk2(v[2], v[3]) << 32); }
#pragma unroll
            for (int o = 1; o < 64; o <<= 1) s += __shfl_xor(s, o);
            if (lane < 16) st0[(size_t)m * 16 + lane] = lane == 0 ? s : 0.f;
        }
#pragma unroll 8
        for (int m = gw; m < 2 * T; m += NGW) {
            const f32x4 v = *((const f32x4*)(pin + (size_t)m * PLE) + lane);
            *((unsigned long long*)(pb + (size_t)m * PLE) + lane) = (unsigned long long)pk2(v[0], v[1]) | ((unsigned long long)pk2(v[2], v[3]) << 32);
        }
    }
    }
    grid.sync();

    using pg8::Gemm; using pg8::StaticOrder; using pg8::RowStat; using pg8::EpiBf16; using pg8::EpiSwiGLU; using pg8::EpiRes;
    typedef EpiRes<false> EpiResN; typedef EpiRes<true> EpiResP; typedef EpiBf16<true, true, false> EpiBfMin; typedef EpiBf16<true, false, false> EpiBfUp; typedef EpiBf16<true, false, true> EpiBfFox; typedef EpiBf16<false, false, false> EpiBfPlain;
#define RUN_GEMM(EPI, ALIGN, Aptr, lda_, Bptr, Mm, Nn, Kk, E) do { int k_ = Kk, n_ = Nn, l_ = lda_; asm volatile("" : "+s"(k_), "+s"(n_), "+s"(l_)); Gemm g_{Aptr, Bptr, Mm, n_, k_, l_}; StaticOrder S_; S_.init(Mm, n_, G, bx); \
        pg8::gemm_phase<EPI, ALIGN, true>(lds3, g_, S_, E); } while (0)

#pragma unroll 1
    for (int l = 0; l < 2; ++l) {
        for (int rep_ = 0; rep_ < REP_FFNIN; ++rep_) { LND(); PH(1) { EpiSwiGLU E{hid, DFF, RowStat{st0, 0xFu, 1.f / DM}};
          RUN_GEMM(EpiSwiGLU, true, (l == 0 ? hb : hb2), DM, (const bf16_t*)(ws + W_F1IN) + (size_t)l * 5632 * 1024, T, 2 * DFF, DM, E); } }
        xcd_barrier(xbar);
        LND(); PH(2) { EpiResN E{l == 0 ? xin : (const float*)out, out, hb, st1, 0.5f, nullptr, RowStat{nullptr, 0u, 0.f}};
          RUN_GEMM(EpiResN, true, hid, DFF, (const bf16_t*)(ws + W_F1OUT) + (size_t)l * 1024 * 2816, T, DM, DFF, E); }
        xcd_barrier(xbar);
        if (l == 0) {
            LND(); PH(3) { EpiBfMin E{zb, zb, zb, DM, DM, -1, RowStat{st1, 0xFu, 1.f / DM}, st0, nullptr, nullptr, -1, nullptr, nullptr, nullptr};
              RUN_GEMM(EpiBfMin, true, hb, DM, (const bf16_t*)(ws + W_MIN), T, 1024, DM, E); }
            xcd_barrier(xbar);
            LND(); PH(10) { EpiBfUp E{qm, qa, qa, 1024, 512, -1, RowStat{st0, 0x3u, 1.f / 512}, nullptr, nullptr, nullptr, -1, nullptr, nullptr, nullptr};
              RUN_GEMM(EpiBfUp, true, zb, DM, (const bf16_t*)(ws + W_UQ), T, 1536, 512, E); }
            LND(); PH(11) { EpiBfUp E{hb, hb, vv, 1024, 1024, 1, RowStat{st0, 0x4u, 1.f / 256}, nullptr, nullptr, nullptr, -1, nullptr, nullptr, nullptr};
              RUN_GEMM(EpiBfUp, true, zb + 512, DM, (const bf16_t*)(ws + W_UKV), T, 2048, 256, E); }
            xcd_barrier(xbar);
            LND(); PH(4) {
                const float* gq = AIN(18); const float* gk = AIN(19);
                const int head = lane >> 2, part = lane & 3;
                float gqr[32], gkr[32];
#pragma unroll
                for (int i = 0; i < 32; ++i) { gqr[i] = part < 3 ? gq[part * 32 + i] : 0.f; gkr[i] = part < 3 ? gk[part * 32 + i] : 0.f; }
                const float C2 = 0.10206207261596577f * LOG2E;
                for (int m = gw; m < T; m += NGW) {
                    float cs[16], sn[16];
                    { const float pf = (float)pos[m];
#pragma unroll
                      for (int i = 0; i < 16; ++i) { const float invf = __builtin_bit_cast(float, __builtin_bit_cast(unsigned, exp2f(-(float)i * 0.8304820237218406f)));
                          const float ang = pf * invf; const double rev = (double)ang * 0.15915494309189535; const float fr = (float)(rev - __builtin_rint(rev));
                          cs[i] = __builtin_amdgcn_cosf(fr); sn[i] = __builtin_amdgcn_sinf(fr); } }
#pragma unroll
                    for (int qk = 1; qk < 2; ++qk) {
                        bf16_t* src;
                        if (qk == 0) src = part < 2 ? qm + (size_t)m * 1024 + head * 64 + part * 32 : qa + (size_t)m * 512 + head * 32;
                        else src = part < 2 ? hb + (size_t)m * 1024 + head * 64 + part * 32 : zb + (size_t)m * 1024 + 768;
                        float v[32];
                        u32x4 w[4];
#pragma unroll
                        for (int i = 0; i < 4; ++i) w[i] = part < 3 ? *(const u32x4*)(src + 8 * i) : (u32x4){0u, 0u, 0u, 0u};
                        float ss = 0.f;
#pragma unroll
                        for (int i = 0; i < 4; ++i)
#pragma unroll
                            for (int j = 0; j < 4; ++j) { v[8 * i + 2 * j] = bflo(w[i][j]); v[8 * i + 2 * j + 1] = bfhi(w[i][j]); }
#pragma unroll
                        for (int i = 0; i < 32; ++i) ss += v[i] * v[i];
                        ss += __shfl_xor(ss, 1); ss += __shfl_xor(ss, 2);
                        const float rstd = __builtin_amdgcn_rsqf(ss * (1.f / 96.f) + EPS) * (qk == 0 ? C2 : 1.f);
#pragma unroll
                        for (int i = 0; i < 32; ++i) v[i] = v[i] * rstd * (qk == 0 ? gqr[i] : gkr[i]);
                        if (part == 2) {
#pragma unroll
                            for (int i = 0; i < 16; ++i) { const float x1 = v[i], x2 = v[16 + i]; v[i] = x1 * cs[i] - x2 * sn[i]; v[16 + i] = x1 * sn[i] + x2 * cs[i]; }
                        }
                        bf16_t* dst = src; size_t dstep = 8;
                        if (qk == 1) { const int bb = m >> 14, sq = m & (SEQ - 1);
                            dst = km + ((size_t)((bb * NH + head) * (SEQ / 64) + (sq >> 6))) * (12 * 512) + (part * 4) * 512 + (sq & 63) * 8; dstep = 512; }
                        if (part < 3) {
#pragma unroll
                            for (int i = 0; i < 4; ++i) { u32x4 o; o.x = pk2(v[8 * i], v[8 * i + 1]); o.y = pk2(v[8 * i + 2], v[8 * i + 3]); o.z = pk2(v[8 * i + 4], v[8 * i + 5]); o.w = pk2(v[8 * i + 6], v[8 * i + 7]); *(u32x4*)(dst + dstep * i) = o; }
                        }
                    }
                }
            }
            xcd_barrier(xbar);
            for (int rep_ = 0; rep_ < REP_ATT; ++rep_) { LND(); PH(5) att::attn_phase<6, true>(lds, qm, qa, km, vv, ob, AIN(18), AIN(19), 96, (const float*)nullptr, pos); }
            xcd_barrier(xbar);
            LND(); PH(2) { EpiResN E{out, out, hb, st1, 1.0f, nullptr, RowStat{nullptr, 0u, 0.f}};
              RUN_GEMM(EpiResN, true, ob, DM, (const bf16_t*)(ws + W_MO), T, DM, DM, E); }
            xcd_barrier(xbar);
        } else {
            LND(); PH(6) { EpiBfFox E{qm, ppb, vv, 1024, 1024, 2, RowStat{st1, 0xFu, 1.f / DM}, nullptr, flog, AIN(22), 12, AIN(23), AIN(24), km};
              RUN_GEMM(EpiBfFox, true, hb, DM, (const bf16_t*)(ws + W_FIN), T, 3328, DM, E); }
            xcd_barrier(xbar);
            LND(); PH(7) {
                LAS double* pre = (LAS double*)lds3;
                LAS float* fl = (LAS float*)(lds3 + 16384);
                LAS float* cl = (LAS float*)(lds3 + 16384 + 8192);
                for (int ch = bx; ch < T / 128; ch += G) {
                    const int t0 = ch * 128, bstart = (t0 / SEQ) * SEQ;
                    { const int hq = tid & 3, rs = tid >> 2; double s0 = 0.0, s1 = 0.0, s2 = 0.0, s3 = 0.0;
#pragma unroll 8
                      for (int tt = bstart + rs; tt < t0; tt += 128) { const f32x4 v = *(const f32x4*)(flog + (size_t)tt * 16 + 4 * hq); s0 += (double)v[0]; s1 += (double)v[1]; s2 += (double)v[2]; s3 += (double)v[3]; }
                      pre[rs * 16 + 4 * hq + 0] = s0; pre[rs * 16 + 4 * hq + 1] = s1; pre[rs * 16 + 4 * hq + 2] = s2; pre[rs * 16 + 4 * hq + 3] = s3; }
                    { const f32x4 v = *((const f32x4*)(flog + (size_t)t0 * 16) + tid); *((LAS f32x4*)fl + tid) = v; }
                    __syncthreads();
                    if (tid < 16) { double run = 0.0; for (int s = 0; s < 128; ++s) run += pre[s * 16 + tid];
                        for (int i = 0; i < 128; ++i) { run += (double)fl[i * 16 + tid]; cl[i * 16 + tid] = (float)(run * 1.4426950408889634); } }
                    __syncthreads();
                    { const int tsub = lane >> 4, hd = lane & 15;
#pragma unroll
                      for (int it = 0; it < 4; ++it) {
                        const int tl = wave * 16 + it * 4 + tsub; const size_t m = (size_t)t0 + tl;
                        const float c = cl[tl * 16 + hd];
                        cgl[m * 16 + hd] = c;
                        const unsigned chi = f2bf(c); const float r1 = c - __builtin_bit_cast(float, chi << 16);
                        const unsigned cmi = f2bf(r1); const float r2 = r1 - __builtin_bit_cast(float, cmi << 16);
                        const unsigned clo = f2bf(r2);
                        const unsigned ONE = 0x3f80u;
                        const int bb = (int)(m >> 14), sq = (int)(m & (SEQ - 1));
                        bf16_t* kim = km + ((size_t)((bb * NH + hd) * (SEQ / 64) + (sq >> 6))) * (10 * 512) + (sq & 63) * 8;
                        bf16_t* qad = qa + m * 256 + hd * 16;
                        const u32x4 zz = (u32x4){0u, 0u, 0u, 0u};
                        u32x4 eq, ek;
                        eq.x = chi | (cmi << 16); eq.y = clo | (ONE << 16); eq.z = ONE | (ONE << 16); eq.w = 0u;
                        ek.x = ONE | (ONE << 16); ek.y = ONE | ((chi ^ 0x8000u) << 16); ek.z = (cmi ^ 0x8000u) | ((clo ^ 0x8000u) << 16); ek.w = 0u;
                        *(u32x4*)qad = eq; *(u32x4*)(qad + 8) = zz;
                        *(u32x4*)(kim + 8 * 512) = ek; *(u32x4*)(kim + 9 * 512) = zz;
                      } }
                    __syncthreads();
                }
            }
            xcd_barrier(xbar);
            for (int rep_ = 0; rep_ < REP_ATT; ++rep_) { LND(); PH(8) att::attn_phase<5, false>(lds, qm, qa, km, vv, ob, AIN(23), AIN(24), 64, cgl, pos); }
            xcd_barrier(xbar);
            LND(); PH(2) { EpiResN E{out, out, hb, st1, 1.0f, nullptr, RowStat{nullptr, 0u, 0.f}};
              RUN_GEMM(EpiResN, true, ob, DM, (const bf16_t*)(ws + W_FO), T, DM, DM, E); }
            xcd_barrier(xbar);
        }
        for (int rep_ = 0; rep_ < REP_FFNIN; ++rep_) { LND(); PH(1) { EpiSwiGLU E{hid, DFF, RowStat{st1, 0xFu, 1.f / DM}};
          RUN_GEMM(EpiSwiGLU, true, hb, DM, (const bf16_t*)(ws + W_F2IN) + (size_t)l * 5632 * 1024, T, 2 * DFF, DM, E); } }
        xcd_barrier(xbar);
        LND(); PH(2) { EpiResN E{out, out, hb, st0, 0.5f, nullptr, RowStat{nullptr, 0u, 0.f}};
          RUN_GEMM(EpiResN, true, hid, DFF, (const bf16_t*)(ws + W_F2OUT) + (size_t)l * 1024 * 2816, T, DM, DFF, E); }
        xcd_barrier(xbar);
        LND(); PH(9) { EpiBfPlain E{ppb, ppb, ppb, DM, DM, -1, RowStat{nullptr, 0u, 0.f}, nullptr, nullptr, nullptr, -1, nullptr, nullptr, nullptr};
          RUN_GEMM(EpiBfPlain, true, pb + (size_t)l * T * PLE, PLE, (const bf16_t*)(ws + W_PP) + (size_t)l * 1024 * 256, T, DM, PLE, E); }
        asm volatile("s_waitcnt vmcnt(0)" ::: "memory");
        LND(); PH(9) { EpiResP E{out, out, hb2, st1, 1.0f, ppb, RowStat{st0, 0xFu, 1.f / DM}};
          RUN_GEMM(EpiResP, true, hb, DM, (const bf16_t*)(ws + W_PG) + (size_t)l * 1024 * 1024, T, DM, DM, E); }
        if (l == 0) xcd_barrier(xbar);
        { const size_t tmp = st0_off; st0_off = st1_off; st1_off = tmp; }
    }
}

#undef ws
#undef out
#undef xin
#undef pin
#undef pos
#undef AIN
#undef hb
#undef hb2
#undef ppb
#undef pb
#undef st0
#undef st1
#undef flog
#undef cgl
#undef hid
#undef qm
#undef km
#undef vv
#undef qa
#undef zb
#undef ob
#undef LND
#undef lane
#undef wave
#undef gw
#undef NGW
constexpr int LDS_BYTES = 147456;

extern "C" void kernel_launch(void* const* d_in, const int* in_sizes, int n_in, void* d_out, int out_size, void* d_ws, size_t ws_size, hipStream_t stream) {
    static int grid = 0;
    if (grid == 0) {
        if (n_in != 26 || out_size != T * DM || ws_size < WS_NEED) { fprintf(stderr, "kernel_launch: unexpected shapes (n_in %d out %d ws %zu)\n", n_in, out_size, ws_size); grid = -1; return; }
        int dev = 0, cus = 0, per_cu = 0;
        hipGetDevice(&dev); hipDeviceGetAttribute(&cus, hipDeviceAttributeMultiprocessorCount, dev);
        if (hipFuncSetAttribute((const void*)fwd_mega, hipFuncAttributeMaxDynamicSharedMemorySize, LDS_BYTES) != hipSuccess) { fprintf(stderr, "kernel_launch: hipFuncSetAttribute failed\n"); grid = -1; return; }
        hipOccupancyMaxActiveBlocksPerMultiprocessor(&per_cu, (const void*)fwd_mega, 512, LDS_BYTES);
        if (per_cu < 1) { fprintf(stderr, "kernel_launch: occupancy query says %d\n", per_cu); per_cu = 1; }
        (void)hipGetLastError();
        grid = cus;
    }
    if (grid < 0) return;
    if (hipMemsetAsync(d_ws, 0, 65536, stream) != hipSuccess) { fprintf(stderr, "kernel_launch: memset failed\n"); return; }
    Args a{};
    for (int i = 0; i < 26; ++i) a.in[i] = (const float*)d_in[i];
    a.out = (float*)d_out; a.ws = (unsigned char*)d_ws;
    void* args[] = {&a};
    hipError_t e = hipLaunchCooperativeKernel((const void*)fwd_mega, dim3(grid), dim3(512), args, LDS_BYTES, stream);
    if (e != hipSuccess) fprintf(stderr, "cooperative launch failed: %s (grid %d)\n", hipGetErrorString(e), grid);
}
```
